# Optimizing an MI355X kernel written in HIP

```python
import math
import jax, jax.numpy as jnp
from jax import lax
import numpy as np


D_MODEL = 2048
BATCH = 2
SEQ = 4096
DEPTH = 4
DEC_BATCH = 32
DEC_SEQ = 1
PAST_LEN = 16384
PAGE_SIZE = 128

D_MIX = D_MODEL
SSM_HEAD_DIM = 64
D_SSD = D_MIX // 2
SSM_HEADS = D_SSD // SSM_HEAD_DIM
SSM_GROUPS = 2
SSM_HEADS_PER_GROUP = SSM_HEADS // SSM_GROUPS
D_STATE = 128
SSM_CONV = 4
SSD_CHUNK = 128
D_XBC = D_SSD + 2 * SSM_GROUPS * D_STATE
HEAD_DIM = 64
D_ATTN = D_MIX // 4
ATT_HEADS = D_ATTN // HEAD_DIM
KV_HEADS = 2
Q_PER_KV = ATT_HEADS // KV_HEADS
WINDOW = 128
ATT_BLOCK = 128
ROPE_THETA = 10000.0
D_CONV = D_MIX - D_SSD - D_ATTN
SCONV_K = 3
D_FF = ((8 * D_MODEL // 3 + 255) // 256) * 256
FFN_CONV = 3
PROJ_W = D_SSD + D_XBC + SSM_HEADS + D_ATTN + 2 * KV_HEADS * HEAD_DIM + 3 * D_CONV
EPS = 1e-6

kernel_name = "hymba_ssd_swa_shortconv_decoder_step"


def _proj_offsets():
    sizes = [D_SSD, D_XBC, SSM_HEADS, D_ATTN, KV_HEADS * HEAD_DIM, KV_HEADS * HEAD_DIM,
             D_CONV, D_CONV, D_CONV]
    offs, acc = [], 0
    for s in sizes[:-1]:
        acc += s
        offs.append(acc)
    return offs


def rmsnorm(x, w):
    x32 = x.astype(jnp.float32)
    y = x32 * lax.rsqrt(jnp.mean(x32 * x32, axis=-1, keepdims=True) + EPS)
    return (y * w.astype(jnp.float32)).astype(x.dtype)


def causal_dwconv(x, w, prev):
    K = w.shape[0]
    L = x.shape[1]
    xc = jnp.concatenate([prev.astype(x.dtype), x], axis=1)
    y = sum(xc[:, k:k + L] * w[k] for k in range(K))
    return y, xc[:, L:]


def rope(x, pos):
    half = HEAD_DIM // 2
    inv = jnp.power(ROPE_THETA, -jnp.arange(half, dtype=jnp.float32) / half)
    ang = pos[:, None] * inv[None, :]
    cos = jnp.cos(ang)[None, :, None, :]
    sin = jnp.sin(ang)[None, :, None, :]
    x32 = x.astype(jnp.float32)
    x1, x2 = x32[..., :half], x32[..., half:]
    return jnp.concatenate([x1 * cos - x2 * sin, x2 * cos + x1 * sin], axis=-1).astype(x.dtype)


def ssd_scan(x, dt, a, bm, cm, h0, chunk):
    b, L, G, R, P = x.shape
    N = bm.shape[-1]
    nc = L // chunk
    f32 = jnp.float32
    xdt = (x.astype(f32) * dt[..., None]).reshape(b, nc, chunk, G, R, P)
    bc = bm.astype(f32).reshape(b, nc, chunk, G, N)
    cc = cm.astype(f32).reshape(b, nc, chunk, G, N)
    cs = jnp.cumsum((dt * a).reshape(b, nc, chunk, G, R), axis=2)
    causal = jnp.tril(jnp.ones((chunk, chunk), dtype=bool))[None, None, :, :, None, None]
    seg = cs[:, :, :, None] - cs[:, :, None, :]
    decay = jnp.exp(jnp.where(causal, seg, -jnp.inf))
    cb = jnp.einsum('bclgn,bcsgn->bclsg', cc, bc)
    y_diag = jnp.einsum('bclsg,bclsgr,bcsgrp->bclgrp', cb, decay, xdt)
    to_end = jnp.exp(cs[:, :, -1:] - cs)
    chunk_states = jnp.einsum('bclgn,bclgr,bclgrp->bcgrpn', bc, to_end, xdt)
    chunk_decay = jnp.exp(cs[:, :, -1])

    def step(h, inp):
        dec, st = inp
        return dec[..., None, None] * h + st, h

    h_final, h_start = lax.scan(step, h0.astype(f32),
                                (jnp.moveaxis(chunk_decay, 1, 0), jnp.moveaxis(chunk_states, 1, 0)))
    h_start = jnp.moveaxis(h_start, 0, 1)
    y_off = jnp.einsum('bclgn,bcgrpn,bclgr->bclgrp', cc, h_start, jnp.exp(cs))
    return (y_diag + y_off).reshape(b, L, G, R, P), h_final


def sink_attention(q, k, v, valid, sinks):
    s = jnp.einsum('bnqgrd,bnkgd->bngrqk', q, k).astype(jnp.float32) * (HEAD_DIM ** -0.5)
    s = jnp.where(valid[None, :, None, None], s, -jnp.inf)
    sink = sinks.astype(jnp.float32).reshape(KV_HEADS, Q_PER_KV)[None, None, :, :, None, None]
    m = jnp.maximum(jnp.max(s, axis=-1, keepdims=True), sink)
    p = jnp.exp(s - m)
    p = p / (jnp.sum(p, axis=-1, keepdims=True) + jnp.exp(sink - m))
    return jnp.einsum('bngrqk,bnkgd->bnqgrd', p.astype(v.dtype), v)


def hybrid_layer(x, mod, pos0, ssm_h0, ssm_conv_prev, win_k, win_v, sconv_prev, fconv_prev, p):
    b, L, _ = x.shape
    G, R, P, N = SSM_GROUPS, SSM_HEADS_PER_GROUP, SSM_HEAD_DIM, D_STATE
    shift1, scale1, gate1, shift2, scale2, gate2 = jnp.split(mod[:, None, :], 6, axis=-1)

    h = rmsnorm(x, p['norm1_w']) * (1 + scale1) + shift1
    proj = h @ p['w_in']
    z, xbc, dt_raw, q, k, v, g_b, g_c, hc = jnp.split(proj, _proj_offsets(), axis=-1)

    xbc, ssm_conv_new = causal_dwconv(xbc, p['ssm_conv_w'], ssm_conv_prev)
    xbc = jax.nn.silu(xbc + p['ssm_conv_b'])
    xs, bm, cm = jnp.split(xbc, [D_SSD, D_SSD + G * N], axis=-1)
    xs = xs.reshape(b, L, G, R, P)
    bm = bm.reshape(b, L, G, N)
    cm = cm.reshape(b, L, G, N)
    dt = jax.nn.softplus(dt_raw.astype(jnp.float32) + p['dt_bias'].astype(jnp.float32)).reshape(b, L, G, R)
    a = -jnp.exp(p['a_log'].astype(jnp.float32)).reshape(G, R)
    y, ssm_h = ssd_scan(xs, dt, a, bm, cm, ssm_h0.reshape(b, G, R, P, N), math.gcd(L, SSD_CHUNK))
    y = y + p['d_skip'].astype(jnp.float32).reshape(G, R)[:, :, None] * xs.astype(jnp.float32)
    y = y.astype(x.dtype).reshape(b, L, D_SSD) * jax.nn.silu(z)
    y_ssm = rmsnorm(y.reshape(b, L, G, D_SSD // G),
                    p['ssm_norm_w'].reshape(G, D_SSD // G)).reshape(b, L, D_SSD)

    pos = pos0 + jnp.arange(L, dtype=jnp.float32)
    q = rope(rmsnorm(q.reshape(b, L, ATT_HEADS, HEAD_DIM), p['q_norm_w']), pos)
    k = rope(rmsnorm(k.reshape(b, L, KV_HEADS, HEAD_DIM), p['k_norm_w']), pos)
    v = v.reshape(b, L, KV_HEADS, HEAD_DIM)
    if win_k is None:
        nb = L // ATT_BLOCK
        qb = q.reshape(b, nb, ATT_BLOCK, KV_HEADS, Q_PER_KV, HEAD_DIM)
        kb = k.reshape(b, nb, ATT_BLOCK, KV_HEADS, HEAD_DIM)
        vb = v.reshape(b, nb, ATT_BLOCK, KV_HEADS, HEAD_DIM)
        k_prev = jnp.concatenate([jnp.zeros_like(kb[:, :1]), kb[:, :-1]], axis=1)
        v_prev = jnp.concatenate([jnp.zeros_like(vb[:, :1]), vb[:, :-1]], axis=1)
        k_band = jnp.concatenate([k_prev, kb], axis=2)
        v_band = jnp.concatenate([v_prev, vb], axis=2)
        blk = jnp.arange(nb)[:, None, None]
        qpos = blk * ATT_BLOCK + jnp.arange(ATT_BLOCK)[None, :, None]
        kpos = (blk - 1) * ATT_BLOCK + jnp.arange(2 * ATT_BLOCK)[None, None, :]
        diff = qpos - kpos
        valid = (diff >= 0) & (diff <= WINDOW) & (kpos >= 0)
        o = sink_attention(qb, k_band, v_band, valid, p['sinks']).reshape(b, L, D_ATTN)
        new_k, new_v = k[:, L - WINDOW:], v[:, L - WINDOW:]
    else:
        n_buf = win_k.shape[1]
        kc = jnp.concatenate([win_k.astype(k.dtype), k], axis=1)
        vc = jnp.concatenate([win_v.astype(v.dtype), v], axis=1)
        qpos = jnp.arange(L)[:, None] + n_buf
        kpos = jnp.arange(n_buf + L)[None, :]
        diff = qpos - kpos
        valid = ((diff >= 0) & (diff <= WINDOW))[None]
        o = sink_attention(q.reshape(b, 1, L, KV_HEADS, Q_PER_KV, HEAD_DIM), kc[:, None], vc[:, None],
                           valid, p['sinks']).reshape(b, L, D_ATTN)
        new_k, new_v = kc[:, L:], vc[:, L:]

    conv, sconv_new = causal_dwconv(g_c * hc, p['sconv_w'], sconv_prev)
    y_conv = g_b * conv

    mixed = jnp.concatenate([y_ssm, o, y_conv], axis=-1) @ p['w_out']
    x = x + gate1 * mixed

    h2 = rmsnorm(x, p['norm2_w']) * (1 + scale2) + shift2
    gt, u = jnp.split(h2 @ p['w_up'], 2, axis=-1)
    gt, fconv_new = causal_dwconv(gt, p['ffn_conv_w'], fconv_prev)
    y_ff = (jax.nn.silu(gt + p['ffn_conv_b']) * u) @ p['w_down']
    x = x + gate2 * y_ff
    return x, (ssm_h.reshape(b, SSM_HEADS, P, N).astype(ssm_h0.dtype), ssm_conv_new, new_k, new_v,
               sconv_new, fconv_new)


def setup_inputs(seed: int = 0) -> dict:
    key = jax.random.key(seed)
    ks = jax.random.split(key, 40)
    f32 = jnp.float32

    def nrm(k, shape, s=1.0):
        return s * jax.random.normal(k, shape, f32)

    n_buf = min(WINDOW, PAST_LEN)
    dt0 = jnp.exp(jax.random.uniform(ks[20], (DEPTH, SSM_HEADS), f32, math.log(1e-3), math.log(1e-1)))
    return {
        'x_prompt': nrm(ks[0], (BATCH, SEQ, D_MODEL)),
        'x_sample': nrm(ks[1], (DEC_BATCH, DEC_SEQ, D_MODEL)),
        'state_ssm': nrm(ks[2], (DEPTH, DEC_BATCH, SSM_HEADS, SSM_HEAD_DIM, D_STATE), 0.5),
        'state_ssm_conv': nrm(ks[3], (DEPTH, DEC_BATCH, SSM_CONV - 1, D_XBC)),
        'cache_win_k': nrm(ks[4], (DEPTH, DEC_BATCH, n_buf, KV_HEADS, HEAD_DIM)),
        'cache_win_v': nrm(ks[5], (DEPTH, DEC_BATCH, n_buf, KV_HEADS, HEAD_DIM)),
        'state_short_conv': nrm(ks[6], (DEPTH, DEC_BATCH, SCONV_K - 1, D_CONV)),
        'state_ffn_conv': nrm(ks[7], (DEPTH, DEC_BATCH, FFN_CONV - 1, D_FF)),
        'c_prompt': nrm(ks[8], (BATCH, D_MODEL)),
        'c_sample': nrm(ks[9], (DEC_BATCH, D_MODEL)),
        'norm1_w': 1.0 + nrm(ks[10], (DEPTH, D_MODEL), 0.1),
        'norm2_w': 1.0 + nrm(ks[11], (DEPTH, D_MODEL), 0.1),
        'w_ada': nrm(ks[12], (DEPTH, D_MODEL, 6 * D_MODEL), 0.5 * D_MODEL ** -0.5),
        'b_ada': nrm(ks[13], (DEPTH, 6 * D_MODEL), 0.02),
        'w_in': nrm(ks[14], (DEPTH, D_MODEL, PROJ_W), D_MODEL ** -0.5),
        'ssm_conv_w': nrm(ks[15], (DEPTH, SSM_CONV, D_XBC), SSM_CONV ** -0.5),
        'ssm_conv_b': nrm(ks[16], (DEPTH, D_XBC), 0.02),
        'dt_bias': dt0 + jnp.log(-jnp.expm1(-dt0)),
        'a_log': jnp.log(jax.random.uniform(ks[17], (DEPTH, SSM_HEADS), f32, 1.0, 16.0)),
        'd_skip': 1.0 + nrm(ks[18], (DEPTH, SSM_HEADS), 0.1),
        'ssm_norm_w': 1.0 + nrm(ks[19], (DEPTH, D_SSD), 0.1),
        'q_norm_w': 1.0 + nrm(ks[21], (DEPTH, HEAD_DIM), 0.1),
        'k_norm_w': 1.0 + nrm(ks[22], (DEPTH, HEAD_DIM), 0.1),
        'sinks': nrm(ks[23], (DEPTH, ATT_HEADS), 0.5),
        'sconv_w': nrm(ks[24], (DEPTH, SCONV_K, D_CONV), SCONV_K ** -0.5),
        'w_out': nrm(ks[25], (DEPTH, D_MIX, D_MODEL), D_MIX ** -0.5),
        'w_up': nrm(ks[26], (DEPTH, D_MODEL, 2 * D_FF), D_MODEL ** -0.5),
        'ffn_conv_w': nrm(ks[27], (DEPTH, FFN_CONV, D_FF), FFN_CONV ** -0.5),
        'ffn_conv_b': nrm(ks[28], (DEPTH, D_FF), 0.02),
        'w_down': nrm(ks[29], (DEPTH, D_FF, D_MODEL), D_FF ** -0.5),
    }


def reference(x_prompt, x_sample, state_ssm, state_ssm_conv, cache_win_k, cache_win_v,
              state_short_conv, state_ffn_conv, c_prompt, c_sample,
              norm1_w, norm2_w, w_ada, b_ada, w_in, ssm_conv_w, ssm_conv_b, dt_bias, a_log, d_skip,
              ssm_norm_w, q_norm_w, k_norm_w, sinks, sconv_w, w_out, w_up, ffn_conv_w, ffn_conv_b,
              w_down):
    dt_ = x_prompt.dtype
    xp, xs = x_prompt, x_sample
    p_out = [[] for _ in range(6)]
    s_out = [[] for _ in range(6)]
    for l in range(DEPTH):
        p = {'norm1_w': norm1_w[l], 'norm2_w': norm2_w[l], 'w_in': w_in[l],
             'ssm_conv_w': ssm_conv_w[l], 'ssm_conv_b': ssm_conv_b[l], 'dt_bias': dt_bias[l],
             'a_log': a_log[l], 'd_skip': d_skip[l], 'ssm_norm_w': ssm_norm_w[l],
             'q_norm_w': q_norm_w[l], 'k_norm_w': k_norm_w[l], 'sinks': sinks[l],
             'sconv_w': sconv_w[l], 'w_out': w_out[l], 'w_up': w_up[l],
             'ffn_conv_w': ffn_conv_w[l], 'ffn_conv_b': ffn_conv_b[l], 'w_down': w_down[l]}
        mod_p = jax.nn.silu(c_prompt) @ w_ada[l] + b_ada[l]
        mod_s = jax.nn.silu(c_sample) @ w_ada[l] + b_ada[l]
        xp, st_p = hybrid_layer(
            xp, mod_p, 0.0,
            jnp.zeros((BATCH, SSM_HEADS, SSM_HEAD_DIM, D_STATE), dt_),
            jnp.zeros((BATCH, SSM_CONV - 1, D_XBC), dt_),
            None, None,
            jnp.zeros((BATCH, SCONV_K - 1, D_CONV), dt_),
            jnp.zeros((BATCH, FFN_CONV - 1, D_FF), dt_), p)
        xs, st_s = hybrid_layer(
            xs, mod_s, float(PAST_LEN), state_ssm[l], state_ssm_conv[l], cache_win_k[l], cache_win_v[l],
            state_short_conv[l], state_ffn_conv[l], p)
        for i in range(6):
            p_out[i].append(st_p[i])
            s_out[i].append(st_s[i])
    p_ssm, p_ssm_conv, p_win_k, p_win_v, p_short_conv, p_ffn_conv = [jnp.stack(a, axis=0) for a in p_out]
    s_ssm, s_ssm_conv, s_win_k, s_win_v, s_short_conv, s_ffn_conv = [jnp.stack(a, axis=0) for a in s_out]
    return (xp, xs, p_ssm, p_ssm_conv, p_win_k, p_win_v, p_short_conv, p_ffn_conv,
            s_ssm, s_ssm_conv, s_win_k, s_win_v, s_short_conv, s_ffn_conv)
```

```cpp
#include <hip/hip_runtime.h>
#include <cstdio>
#include <cstdint>
namespace pg8 {
#define PG8_LAS __attribute__((address_space(3)))
typedef unsigned short bf16_t;
typedef short bf16x8 __attribute__((ext_vector_type(8)));
typedef float f32x4 __attribute__((ext_vector_type(4)));
typedef unsigned u32x4 __attribute__((ext_vector_type(4)));
constexpr int BM = 256, BK = 64, HALF = 128, HTB = HALF * BK * 2  , STAGE_BYTES = 8 * HTB, NXCD = 8, WGM = 8;

__host__ __device__ __forceinline__ int lds_byte(int r, int c) { const int st = (r >> 4) * 2 + (c >> 5), rr = r & 15, cc = c & 31, ob = rr * 64 + cc * 2; return st * 1024 + (ob ^ (((ob >> 9) & 1) << 5)); }
__host__ __device__ __forceinline__ void stage_rc(int b, int& R, int& C) { const int st = b / 1024, sb = b % 1024, swz = sb ^ (((sb >> 9) & 1) << 5); R = (st >> 1) * 16 + swz / 64; C = (st & 1) * 32 + (swz % 64) / 2; }
__host__ __device__ __forceinline__ int perm32(int rho) { const int n = rho >> 4, i = rho & 15; return 8 * (i >> 2) + 4 * n + (i & 3); }

struct Unit { int pm, pn; };
struct Gemm { const bf16_t* A; const bf16_t* Bt; int M, N, K; };

struct StaticOrder {
    int nM, nN, nwg, G, c;
    __host__ __device__ void init(int M, int N, int G_, int c_) { nM = M / BM; nN = N / BM; nwg = nM * nN; G = G_; c = c_; }
    __host__ __device__ bool next(int i, Unit& u) const {
        const long L = (long)i * G + c; if (L >= nwg) return false;
        int wgid = (int)L; { const int q = nwg / NXCD, r = nwg % NXCD, xcd = wgid % NXCD, off = wgid / NXCD; wgid = (xcd < r ? xcd * (q + 1) : r * (q + 1) + (xcd - r) * q) + off; }
        const int nig = WGM * nN, gid = wgid / nig, fm = gid * WGM, gsz = (nM - fm) < WGM ? (nM - fm) : WGM;
        u.pm = fm + ((wgid % nig) % gsz); u.pn = (wgid % nig) / gsz; return true;
    }
    __device__ __forceinline__ void a_ready(const Unit&) const {}
    __device__ __forceinline__ void done(const Unit&) const {}
};

__device__ __forceinline__ unsigned cvt_pk_bf16(float lo, float hi) { unsigned r; asm volatile("v_cvt_pk_bf16_f32 %0, %1, %2" : "=v"(r) : "v"(lo), "v"(hi)); return r; }
typedef float f32x2 __attribute__((ext_vector_type(2)));
template <class Epi, class Sched, bool ALIGN_EPI = false, bool SP2 = false>
__device__ __forceinline__ void gemm_phase(PG8_LAS unsigned char* lds, const Gemm g, const Sched& S, const Epi& E) {
    int tid_ = threadIdx.x; asm volatile("" : "+v"(tid_));
    const int tid = tid_, wid = __builtin_amdgcn_readfirstlane(tid >> 6), lane = tid & 63, wr = wid >> 2, wc = wid & 3, fr = lane & 15, fq = lane >> 4;
    const int K = g.K, nt = K / BK;
    unsigned voffA[2], voffB[2];
#pragma unroll
    for (int i = 0; i < 2; ++i) { int R, C; stage_rc(tid * 16 + i * 8192, R, C); const int Rb = Epi::PERM ? ((R & ~31) + perm32(R & 31)) : R;
        voffA[i] = (unsigned)(R * K + C) * 2u; voffB[i] = (unsigned)(Rb * K + C) * 2u; }
    const size_t kstep = (size_t)(BK * 2);
    const size_t hstep = (size_t)HALF * K * 2;
    const size_t tstep = 2 * hstep;
    const unsigned ldsw = (unsigned)wid * 1024u;
    const int aoff = lds_byte(wr * 64 + fr, fq * 8), boff = lds_byte(wc * 32 + fr, fq * 8);
#define PG8_SA(b, h) (((b) * 2 + (h)) * HTB)
#define PG8_SB(b, h) ((4 + (b) * 2 + (h)) * HTB)
#define PG8_STAGE(bufoff, gbase, voff) do { _Pragma("unroll") for (int _i = 0; _i < 2; ++_i) \
        __builtin_amdgcn_global_load_lds((const unsigned*)((const char*)(gbase) + (voff)[_i]), (PG8_LAS unsigned*)(lds + (bufoff) + ldsw + _i * 8192), 16, 0, 0); } while (0)
#define PG8_LDA(dst, b, h) do { _Pragma("unroll") for (int m = 0; m < 4; ++m) _Pragma("unroll") for (int k = 0; k < 2; ++k) dst[m][k] = *(const PG8_LAS bf16x8*)(lds + PG8_SA(b, h) + aoff + m * 2048 + k * 1024); } while (0)
#define PG8_LDB(dst, b, h) do { _Pragma("unroll") for (int n = 0; n < 2; ++n) _Pragma("unroll") for (int k = 0; k < 2; ++k) dst[n][k] = *(const PG8_LAS bf16x8*)(lds + PG8_SB(b, h) + boff + n * 2048 + k * 1024); } while (0)
#define PG8_MMA(ai, bj, At, Bt) do { __builtin_amdgcn_s_setprio(1); _Pragma("unroll") for (int m = 0; m < 4; ++m) _Pragma("unroll") for (int n = 0; n < 2; ++n) _Pragma("unroll") for (int k = 0; k < 2; ++k) \
        acc[ai][bj][m][n] = __builtin_amdgcn_mfma_f32_16x16x32_bf16(Bt[n][k], At[m][k], acc[ai][bj][m][n], 0, 0, 0); __builtin_amdgcn_s_setprio(0); } while (0)
#define PG8_WAIT_V(n) asm volatile("s_waitcnt vmcnt(" #n ")" ::: "memory")
#define PG8_WAIT_L(n) asm volatile("s_waitcnt lgkmcnt(" #n ")" ::: "memory")
#define PG8_BAR __builtin_amdgcn_s_barrier()
#define PG8_SCHED __builtin_amdgcn_sched_barrier(0)
    Unit cur, nxt; int ui = 0;
    if (!S.next(0, cur)) return;
    f32x4 acc[2][2][4][2];
#pragma unroll
    for (int a = 0; a < 2; ++a)
#pragma unroll
        for (int b = 0; b < 2; ++b)
#pragma unroll
            for (int m = 0; m < 4; ++m)
#pragma unroll
                for (int n = 0; n < 2; ++n) acc[a][b][m][n] = (f32x4){0.f, 0.f, 0.f, 0.f};
    bf16x8 At[4][2], B0[2][2], B1[2][2];
    const char* cA = (const char*)g.A + (size_t)cur.pm * tstep; const char* cB = (const char*)g.Bt + (size_t)cur.pn * tstep;
    S.a_ready(cur);
    if constexpr (SP2) {
        PG8_STAGE(PG8_SB(0, 0), cB, voffB); PG8_STAGE(PG8_SB(0, 1), cB + hstep, voffB); PG8_STAGE(PG8_SA(0, 0), cA, voffA); PG8_STAGE(PG8_SA(0, 1), cA + hstep, voffA);
        if (wr == 1) PG8_BAR;
        PG8_WAIT_V(2); PG8_BAR;
        PG8_STAGE(PG8_SB(1, 0), cB + kstep, voffB); PG8_STAGE(PG8_SA(1, 0), cA + kstep, voffA); PG8_STAGE(PG8_SB(1, 1), cB + hstep + kstep, voffB);
        PG8_WAIT_V(6); PG8_BAR;
    } else {
        PG8_STAGE(PG8_SB(0, 0), cB, voffB); PG8_STAGE(PG8_SA(0, 0), cA, voffA); PG8_STAGE(PG8_SB(0, 1), cB + hstep, voffB); PG8_STAGE(PG8_SA(0, 1), cA + hstep, voffA);
        if (wr == 1) PG8_BAR;
        PG8_WAIT_V(4); PG8_BAR;
        PG8_STAGE(PG8_SB(1, 0), cB + kstep, voffB); PG8_STAGE(PG8_SA(1, 0), cA + kstep, voffA); PG8_STAGE(PG8_SB(1, 1), cB + hstep + kstep, voffB);
        PG8_WAIT_V(6); PG8_BAR;
    }
    for (;;) {
        const bool has_next = S.next(ui + 1, nxt);
        const char* nA = has_next ? (const char*)g.A + (size_t)nxt.pm * tstep : cA; const char* nB = has_next ? (const char*)g.Bt + (size_t)nxt.pn * tstep : cB;
        for (int t = 0; t < nt; t += 2) {
            const bool last = (t == nt - 2);
            const char* a1 = cA + (size_t)(t + 1) * kstep;
            const char* a2 = last ? nA : cA + (size_t)(t + 2) * kstep; const char* b2 = last ? nB : cB + (size_t)(t + 2) * kstep;
            const char* a3 = a2 + kstep; const char* b3 = b2 + kstep;
            if (last && has_next) S.a_ready(nxt);
            if constexpr (SP2) {
            PG8_LDB(B0, 0, 0); PG8_LDB(B1, 0, 1); PG8_SCHED; PG8_LDA(At, 0, 0); PG8_STAGE(PG8_SA(1, 1), a1 + hstep, voffA);
            PG8_WAIT_V(8); PG8_WAIT_L(0); PG8_BAR; PG8_MMA(0, 0, At, B0); PG8_MMA(0, 1, At, B1); PG8_BAR; PG8_SCHED;
            PG8_LDA(At, 0, 1); PG8_STAGE(PG8_SB(0, 0), b2, voffB); PG8_STAGE(PG8_SB(0, 1), b2 + hstep, voffB); PG8_STAGE(PG8_SA(0, 0), a2, voffA);
            PG8_WAIT_V(8); PG8_WAIT_L(0); PG8_BAR; PG8_MMA(1, 0, At, B0); PG8_MMA(1, 1, At, B1); PG8_BAR; PG8_SCHED;
            PG8_LDB(B0, 1, 0); PG8_LDB(B1, 1, 1); PG8_SCHED; PG8_LDA(At, 1, 0); PG8_STAGE(PG8_SA(0, 1), a2 + hstep, voffA);
            PG8_WAIT_V(8); PG8_WAIT_L(0); PG8_BAR; PG8_MMA(0, 0, At, B0); PG8_MMA(0, 1, At, B1); PG8_BAR; PG8_SCHED;
            PG8_LDA(At, 1, 1); PG8_STAGE(PG8_SB(1, 0), b3, voffB); PG8_STAGE(PG8_SB(1, 1), b3 + hstep, voffB); PG8_STAGE(PG8_SA(1, 0), a3, voffA);
            PG8_WAIT_V(8); PG8_WAIT_L(0); PG8_BAR; PG8_MMA(1, 0, At, B0); PG8_MMA(1, 1, At, B1); PG8_BAR; PG8_SCHED;
            } else {
            PG8_LDB(B0, 0, 0); PG8_SCHED; PG8_LDA(At, 0, 0); PG8_STAGE(PG8_SA(1, 1), a1 + hstep, voffA);
            PG8_WAIT_L(8); PG8_BAR; PG8_WAIT_L(0); PG8_MMA(0, 0, At, B0); PG8_BAR; PG8_SCHED;
            PG8_LDB(B1, 0, 1); PG8_STAGE(PG8_SB(0, 0), b2, voffB);
            PG8_BAR; PG8_WAIT_L(0); PG8_MMA(0, 1, At, B1); PG8_BAR;
            PG8_LDA(At, 0, 1); PG8_STAGE(PG8_SA(0, 0), a2, voffA);
            PG8_BAR; PG8_WAIT_L(0); PG8_MMA(1, 0, At, B0); PG8_BAR; PG8_SCHED;
            PG8_STAGE(PG8_SB(0, 1), b2 + hstep, voffB);
            PG8_WAIT_V(6); PG8_BAR; PG8_MMA(1, 1, At, B1); PG8_BAR;
            PG8_LDB(B0, 1, 0); PG8_SCHED; PG8_LDA(At, 1, 0); PG8_STAGE(PG8_SA(0, 1), a2 + hstep, voffA);
            PG8_WAIT_L(8); PG8_BAR; PG8_WAIT_L(0); PG8_MMA(0, 0, At, B0); PG8_BAR; PG8_SCHED;
            PG8_LDB(B1, 1, 1); PG8_STAGE(PG8_SB(1, 0), b3, voffB);
            PG8_BAR; PG8_WAIT_L(0); PG8_MMA(0, 1, At, B1); PG8_BAR;
            PG8_LDA(At, 1, 1); PG8_STAGE(PG8_SA(1, 0), a3, voffA);
            PG8_BAR; PG8_WAIT_L(0); PG8_MMA(1, 0, At, B0); PG8_BAR; PG8_SCHED;
            PG8_STAGE(PG8_SB(1, 1), b3 + hstep, voffB);
            PG8_WAIT_V(6); PG8_BAR; PG8_MMA(1, 1, At, B1); PG8_BAR;
            }
        }
        if constexpr (ALIGN_EPI) { if (wr == 0) PG8_BAR; }
        if constexpr (!Epi::AFTER_DRAIN) { E(acc, cur, wr, wc, fr, fq); S.done(cur); }
        if (!has_next) break;
#pragma unroll
        for (int a = 0; a < 2; ++a)
#pragma unroll
            for (int b = 0; b < 2; ++b)
#pragma unroll
                for (int m = 0; m < 4; ++m)
#pragma unroll
                    for (int n = 0; n < 2; ++n) acc[a][b][m][n] = (f32x4){0.f, 0.f, 0.f, 0.f};
        cur = nxt; cA = nA; cB = nB; ++ui;
        if constexpr (ALIGN_EPI) { if (wr == 1) PG8_BAR; }
    }
    PG8_WAIT_V(0);
    if constexpr (!ALIGN_EPI) { if (wr == 0) PG8_BAR; }
    PG8_BAR;
    if constexpr (Epi::AFTER_DRAIN) { E.fused(acc, cur, wr, wc, fr, fq, lds, wid, lane); S.done(cur); }
#undef PG8_SA
#undef PG8_SB
#undef PG8_STAGE
#undef PG8_LDA
#undef PG8_LDB
#undef PG8_MMA
#undef PG8_WAIT_V
#undef PG8_WAIT_L
#undef PG8_BAR
#undef PG8_SCHED
}
}

#ifndef PG8_SP2
#define PG8_SP2 true
#endif
#ifndef PG8_ALIGN
#define PG8_ALIGN true
#endif
#define GAS __attribute__((address_space(1)))
#define LAS __attribute__((address_space(3)))
typedef unsigned short bf16;
typedef unsigned v4u __attribute__((ext_vector_type(4)));
typedef float f32x4 __attribute__((ext_vector_type(4)));
typedef short bf16x8 __attribute__((ext_vector_type(8)));
typedef GAS unsigned gu32;
typedef GAS unsigned long long gu64;
#define RLX_AGENT __ATOMIC_RELAXED, __HIP_MEMORY_SCOPE_AGENT
#define LDS_WAIT() asm volatile("s_waitcnt lgkmcnt(0)" ::: "memory")
#define VM_WAIT() asm volatile("s_waitcnt vmcnt(0)" ::: "memory")
__device__ __forceinline__ unsigned long long rt() { return __builtin_amdgcn_s_memrealtime(); }
__device__ __forceinline__ unsigned f2bf(float f) { unsigned u = __builtin_bit_cast(unsigned, f); return (u + 0x7fffu + ((u >> 16) & 1u)) >> 16; }
__device__ __forceinline__ unsigned pk2(float lo, float hi) { return f2bf(lo) | (f2bf(hi) << 16); }
#define XB_TMO      128
#define XB_XCNT(j)  (256  + 64 * (j))
#define XB_XSUB(j)  (1280 + 64 * (j))
#define XB_XGEN(j)  (2304 + 64 * (j))
#define XB_TOP      3328
#define XB_TOPGEN   3392
#define XCD_BAR_WORDS 3456
#define XB_SPIN_CAP (1u << 18)

__device__ __forceinline__ unsigned xb_ld(unsigned* p)              { return __hip_atomic_load(p, __ATOMIC_RELAXED, __HIP_MEMORY_SCOPE_AGENT); }
__device__ __forceinline__ unsigned xb_add(unsigned* p, unsigned v) { return __hip_atomic_fetch_add(p, v, __ATOMIC_RELAXED, __HIP_MEMORY_SCOPE_AGENT); }
__device__ __forceinline__ unsigned xb_xcc_id() { return (unsigned)__builtin_amdgcn_s_getreg((3 << 11) | 20) & 0xFu; }
#define XB_SPIN(cond, bar) do { unsigned _sp = 0; while (cond) { __builtin_amdgcn_s_sleep(1); \
    if ((++_sp & 255u) == 0u) { if (xb_ld(&(bar)[XB_TMO])) break; if (_sp > XB_SPIN_CAP) { atomicAdd(&(bar)[XB_TMO], 1u); break; } } } } while (0)

struct XcdBarrier {
    unsigned* bar; unsigned x;
    volatile LAS unsigned* st;
};

__device__ __forceinline__ XcdBarrier xcd_barrier_post(unsigned* bar, volatile LAS unsigned* st) {
    XcdBarrier b; b.bar = bar; b.x = xb_xcc_id(); b.st = st;
    if (threadIdx.x == 0) (void)xb_add(&bar[XB_XCNT(b.x)], 1u);
    return b;
}
__device__ __forceinline__ void xcd_barrier_complete(unsigned* bar, unsigned x, unsigned& nloc, unsigned& nx) {
    const unsigned G = gridDim.x * gridDim.y * gridDim.z;
    unsigned sum, cnt, mine, sp = 0u;
    for (;;) {
        sum = 0u; cnt = 0u; mine = 0u;
#pragma unroll
        for (unsigned j = 0; j < 16; ++j) { const unsigned c = xb_ld(&bar[XB_XCNT(j)]); sum += c; cnt += (c > 0u) ? 1u : 0u; mine = (j == x) ? c : mine; }
        if (sum == G) break;
        __builtin_amdgcn_s_sleep(1);
        if ((++sp & 255u) == 0u) { if (xb_ld(&bar[XB_TMO])) break; if (sp > XB_SPIN_CAP) { atomicAdd(&bar[XB_TMO], 1u); break; } }
    }
    nloc = mine > 0u ? mine : 1u; nx = cnt > 0u ? cnt : 1u;
}

__device__ __forceinline__ void xcd_barrier(const XcdBarrier& b) {
    asm volatile("s_waitcnt vmcnt(0)" ::: "memory");
    __syncthreads();
    if (threadIdx.x == 0) {
        unsigned* bar = b.bar;
        __builtin_amdgcn_s_waitcnt(0);
        unsigned nloc = b.st[0], nx = b.st[1];
        if (nloc == 0u) { xcd_barrier_complete(bar, b.x, nloc, nx); b.st[0] = nloc; b.st[1] = nx; }
        const unsigned old = xb_add(&bar[XB_XSUB(b.x)], 1u);
        const unsigned gen = old / nloc;
        if (old + 1u == (gen + 1u) * nloc) {
            __builtin_amdgcn_fence(__ATOMIC_RELEASE, "agent");
            asm volatile("s_waitcnt vmcnt(0)" ::: "memory");
            const unsigned og = xb_add(&bar[XB_TOP], 1u);
            const unsigned tg = og / nx;
            if (og + 1u == (tg + 1u) * nx) xb_add(&bar[XB_TOPGEN], 1u);
            else XB_SPIN(xb_ld(&bar[XB_TOPGEN]) == tg, bar);
            __builtin_amdgcn_fence(__ATOMIC_ACQUIRE, "agent");
            xb_add(&bar[XB_XGEN(b.x)], 1u);
            asm volatile("s_waitcnt vmcnt(0)" ::: "memory");
        } else {
            XB_SPIN(xb_ld(&bar[XB_XGEN(b.x)]) == gen, bar);
            __builtin_amdgcn_fence(__ATOMIC_ACQUIRE, "agent");
            asm volatile("s_waitcnt vmcnt(0)" ::: "memory");
        }
    }
    __syncthreads();
}

constexpr int NWAVES = 8, NT = 512;
constexpr int DM = 2048, SEQ = 4096, NBP = 2, MP = NBP * SEQ, MS = 32, MT = MP + MS, DEPTH = 4;
constexpr int DSSD = 1024, DXBC = 1536, NH = 16, HP = 64, DST = 128;
constexpr int NQH = 8, NKV = 2, HD = 64, WIN = 128;
constexpr int DCONV = 512, DFF = 5632;
constexpr int NPROJ = 5120, PP = 4864, PSP = 4880;
constexpr int C_Z = 0, C_X = 1024, C_B = 2048, C_C = 2304, C_Q = 2560, C_K = 3072, C_V = 3200, C_GB = 3328, C_GC = 3840, C_HC = 4352, C_DT = 4864;
constexpr int NMOD = 12288, NMR = 34;
constexpr float EPS = 1e-6f;
constexpr int NCH = 64, CL = 64;

constexpr size_t O_YP = 0;
constexpr size_t O_YS = O_YP + (size_t)MP * DM;
constexpr size_t O_PSSM = O_YS + (size_t)MS * DM;
constexpr size_t O_PSSMCONV = O_PSSM + (size_t)DEPTH * NBP * NH * HP * DST;
constexpr size_t O_PWK = O_PSSMCONV + (size_t)DEPTH * NBP * 3 * DXBC;
constexpr size_t O_PWV = O_PWK + (size_t)DEPTH * NBP * WIN * NKV * HD;
constexpr size_t O_PSC = O_PWV + (size_t)DEPTH * NBP * WIN * NKV * HD;
constexpr size_t O_PFC = O_PSC + (size_t)DEPTH * NBP * 2 * DCONV;
constexpr size_t O_SSSM = O_PFC + (size_t)DEPTH * NBP * 2 * DFF;
constexpr size_t O_SSSMCONV = O_SSSM + (size_t)DEPTH * MS * NH * HP * DST;
constexpr size_t O_SWK = O_SSSMCONV + (size_t)DEPTH * MS * 3 * DXBC;
constexpr size_t O_SWV = O_SWK + (size_t)DEPTH * MS * WIN * NKV * HD;
constexpr size_t O_SSC = O_SWV + (size_t)DEPTH * MS * WIN * NKV * HD;
constexpr size_t O_SFC = O_SSC + (size_t)DEPTH * MS * 2 * DCONV;
constexpr size_t O_END = O_SFC + (size_t)DEPTH * MS * 2 * DFF;
static_assert(O_END == 41422848, "output size");

constexpr size_t MiB = 1u << 20;
constexpr size_t WS_CTL = 0, CTL_ZERO_BYTES = 1 * MiB;
constexpr size_t WS_WIN = 2 * MiB;
constexpr size_t WS_WOUT = 82 * MiB;
constexpr size_t WS_WUP = 114 * MiB;
constexpr size_t WS_WDN = 290 * MiB;
constexpr size_t WS_HA = 378 * MiB;
constexpr size_t WS_PROJ = 411 * MiB;
constexpr size_t WS_DT = 487 * MiB;
constexpr size_t WS_PROJS = 488 * MiB;
constexpr size_t WS_ST = 489 * MiB;
constexpr size_t WS_DECAY = 521 * MiB;
constexpr size_t WS_MIX = 522 * MiB;
constexpr size_t WS_GU = 555 * MiB;
constexpr size_t WS_GUS = 731 * MiB;
constexpr size_t WS_ACT = 733 * MiB;
constexpr size_t WS_MOD = 822 * MiB;
constexpr size_t WS_ROPE = 829 * MiB;
constexpr size_t WS_END = 831 * MiB;
constexpr int CW_BAR = 4096;

constexpr int RING_OFF = 0, RING_BYTES = 131072;
constexpr int LDSCTL_OFF = RING_BYTES, MISC_OFF = LDSCTL_OFF + 320;
constexpr int LDS_BYTES = 147456;

typedef float f32x16 __attribute__((ext_vector_type(16)));
typedef float f32x2_t __attribute__((ext_vector_type(2)));
typedef __bf16 bf16x2_t __attribute__((ext_vector_type(2)));
typedef short s16x4 __attribute__((ext_vector_type(4)));
typedef short v4i16_t __attribute__((ext_vector_type(4)));
typedef unsigned v2u __attribute__((ext_vector_type(2)));

struct Args { const float* in[30]; float* out; unsigned char* ws; };
constexpr int LARGS_OFF = 131072 + 1024;
struct LA {
    __device__ __forceinline__ unsigned long long ld(int i) const { const unsigned long long v = *(const __attribute__((address_space(3))) unsigned long long*)(unsigned)(LARGS_OFF + 8 * i);
        const unsigned lo = __builtin_amdgcn_readfirstlane((unsigned)v), hi = __builtin_amdgcn_readfirstlane((unsigned)(v >> 32)); return ((unsigned long long)hi << 32) | lo; }
    __device__ __forceinline__ const float* I(int i) const { return (const float*)ld(i); }
    __device__ __forceinline__ float* O() const { return (float*)ld(30); }
    __device__ __forceinline__ unsigned char* W() const { return (unsigned char*)ld(31); }
};

#define DI __device__ __forceinline__
DI unsigned cvtpk(float lo, float hi) { f32x2_t v = {lo, hi}; bf16x2_t b = __builtin_convertvector(v, bf16x2_t); return __builtin_bit_cast(unsigned, b); }
DI float bflo(unsigned u) { return __uint_as_float(u << 16); }
DI float bfhi(unsigned u) { return __uint_as_float(u & 0xffff0000u); }
DI void unpack8(const v4u v, float* f) { f[0] = bflo(v.x); f[1] = bfhi(v.x); f[2] = bflo(v.y); f[3] = bfhi(v.y); f[4] = bflo(v.z); f[5] = bfhi(v.z); f[6] = bflo(v.w); f[7] = bfhi(v.w); }
DI void unpack4(const v2u v, float* f) { f[0] = bflo(v.x); f[1] = bfhi(v.x); f[2] = bflo(v.y); f[3] = bfhi(v.y); }
DI v4u pack8(const float* f) { v4u o; o.x = cvtpk(f[0], f[1]); o.y = cvtpk(f[2], f[3]); o.z = cvtpk(f[4], f[5]); o.w = cvtpk(f[6], f[7]); return o; }
DI float silu_f(float x) { return x / (1.f + __expf(-x)); }
DI float softplus_f(float x) { return x > 20.f ? x : log1pf(__expf(x)); }
DI float wave_sum(float v) {
#pragma unroll
    for (int o = 1; o < 64; o <<= 1) v += __shfl_xor(v, o);
    return v;
}
DI float wave_max(float v) {
#pragma unroll
    for (int o = 1; o < 64; o <<= 1) v = fmaxf(v, __shfl_xor(v, o));
    return v;
}
DI float wave_incl_scan(float v, int lane) {
#pragma unroll
    for (int o = 1; o < 64; o <<= 1) { const float t = __shfl_up(v, o); if (lane >= o) v += t; }
    return v;
}
DI int crow(int reg, int h) { return (reg & 3) + 8 * (reg >> 2) + 4 * h; }
DI s16x4 tr_rd(const LAS unsigned char* p) { return __builtin_bit_cast(s16x4, __builtin_amdgcn_ds_read_tr16_b64_v4i16((LAS v4i16_t*)p)); }
DI bf16x8 tr_pair(const LAS unsigned char* plo, const LAS unsigned char* phi) { const s16x4 lo = tr_rd(plo), hi = tr_rd(phi); return __builtin_shufflevector(lo, hi, 0, 1, 2, 3, 4, 5, 6, 7); }
#define MFMA32(a, b, c) __builtin_amdgcn_mfma_f32_32x32x16_bf16((a), (b), (c), 0, 0, 0)
#define MFMA16(a, b, c) __builtin_amdgcn_mfma_f32_16x16x32_bf16((a), (b), (c), 0, 0, 0)
DI bf16x8 pack_frag(const f32x16& x, int s) {
    v4u p; p.x = cvtpk(x[8 * s + 0], x[8 * s + 1]); p.y = cvtpk(x[8 * s + 2], x[8 * s + 3]); p.z = cvtpk(x[8 * s + 4], x[8 * s + 5]); p.w = cvtpk(x[8 * s + 6], x[8 * s + 7]);
    return __builtin_bit_cast(bf16x8, p);
}
DI f32x16 zero16() { f32x16 z; for (int i = 0; i < 16; ++i) z[i] = 0.f; return z; }

template <bool WINMAP>
DI void p0_transpose_item(const float* W, int K, int Nsrc, int Ndst, bf16* WT, LAS float* scr, int item, int lane) {
    const int nblk = Ndst / 32, kb = item / nblk, nb = item % nblk, k0 = 64 * kb, n0 = 32 * nb;
    int src = n0 + (lane & 31); bool ok = true;
    if (WINMAP) { const int n = src; if (n < 2560) src = n; else if (n < 4864) src = n + 16; else if (n < 4880) src = n - 4864 + 2560; else { ok = false; src = 0; } }
#pragma unroll 8
    for (int i = 0; i < 32; ++i) { const int kk = 2 * i + (lane >> 5); const float v = W[(size_t)(k0 + kk) * Nsrc + src]; scr[kk * 33 + (lane & 31)] = ok ? v : 0.f; }
    LDS_WAIT(); asm volatile("" ::: "memory");
    const int c = lane & 7;
#pragma unroll
    for (int j = 0; j < 4; ++j) { const int n = (lane >> 3) + 8 * j; const LAS float* s = scr + (8 * c) * 33 + n;
        v4u o; o.x = cvtpk(s[0 * 33], s[1 * 33]); o.y = cvtpk(s[2 * 33], s[3 * 33]); o.z = cvtpk(s[4 * 33], s[5 * 33]); o.w = cvtpk(s[6 * 33], s[7 * 33]);
        *(GAS v4u*)(WT + (size_t)(n0 + n) * K + k0 + 8 * c) = o; }
    LDS_WAIT(); asm volatile("" ::: "memory");
}

DI void p0_weights(const LA& A, LAS unsigned char* lds, int gw, int NGW, int wave, int lane) {
    LAS float* scr = (LAS float*)(lds + wave * 16384);
    constexpr int I_IN = (DM / 64) * (NPROJ / 32), I_OUT = (DM / 64) * (DM / 32), I_UP = (DM / 64) * (2 * DFF / 32), I_DN = (DFF / 64) * (DM / 32);
    constexpr int I_L = I_IN + I_OUT + I_UP + I_DN;
    for (int it = gw; it < DEPTH * I_L; it += NGW) {
        const int l = it / I_L; int r = it % I_L;
        if (r < I_IN) { p0_transpose_item<true>(A.I(14) + (size_t)l * DM * PSP, DM, PSP, NPROJ, (bf16*)(A.W() + WS_WIN) + (size_t)l * NPROJ * DM, scr, r, lane); continue; } r -= I_IN;
        if (r < I_OUT) { p0_transpose_item<false>(A.I(25) + (size_t)l * DM * DM, DM, DM, DM, (bf16*)(A.W() + WS_WOUT) + (size_t)l * DM * DM, scr, r, lane); continue; } r -= I_OUT;
        if (r < I_UP) { p0_transpose_item<false>(A.I(26) + (size_t)l * DM * 2 * DFF, DM, 2 * DFF, 2 * DFF, (bf16*)(A.W() + WS_WUP) + (size_t)l * 2 * DFF * DM, scr, r, lane); continue; } r -= I_UP;
        p0_transpose_item<false>(A.I(29) + (size_t)l * DFF * DM, DFF, DM, DM, (bf16*)(A.W() + WS_WDN) + (size_t)l * DM * DFF, scr, r, lane);
    }
}

DI void p0_mod(const LA& A, LAS unsigned char* lds, int bid, int G, int tid, int wave, int lane) {
    LAS float* sl = (LAS float*)lds;
    const float* cp = A.I(8); const float* csm = A.I(9);
    float* mod = (float*)(A.W() + WS_MOD);
    for (int u = bid; u < DEPTH * (NMOD / 64); u += G) {
        const int l = u / (NMOD / 64), nb = u % (NMOD / 64);
        const float* W = A.I(12) + (size_t)l * DM * NMOD + nb * 64 + lane;
        float acc[NMR];
#pragma unroll
        for (int r = 0; r < NMR; ++r) acc[r] = 0.f;
        for (int ch = 0; ch < 4; ++ch) {
            __syncthreads();
            for (int i = tid; i < 8 * NMR * 64; i += NT) { const int q = i / (NMR * 64), r = (i / 64) % NMR, kk = i & 63; const int k = q * 256 + ch * 64 + kk;
                const float c = r < 2 ? cp[r * DM + k] : csm[(r - 2) * DM + k]; sl[i] = silu_f(c); }
            __syncthreads();
            const float* Wk = W + (size_t)(wave * 256 + ch * 64) * NMOD;
            const LAS float* sw = sl + wave * NMR * 64;
#pragma unroll 2
            for (int k4 = 0; k4 < 16; ++k4) {
                const float w0 = Wk[(size_t)(4 * k4 + 0) * NMOD], w1 = Wk[(size_t)(4 * k4 + 1) * NMOD], w2 = Wk[(size_t)(4 * k4 + 2) * NMOD], w3 = Wk[(size_t)(4 * k4 + 3) * NMOD];
#pragma unroll
                for (int r = 0; r < NMR; ++r) { const f32x4 s = *(const LAS f32x4*)(sw + r * 64 + 4 * k4); acc[r] += s.x * w0 + s.y * w1 + s.z * w2 + s.w * w3; }
            }
        }
        __syncthreads();
#pragma unroll
        for (int r = 0; r < NMR; ++r) sl[(wave * NMR + r) * 64 + lane] = acc[r];
        __syncthreads();
        for (int i = tid; i < NMR * 64; i += NT) { const int r = i >> 6, n = i & 63; float s = A.I(13)[(size_t)l * NMOD + nb * 64 + n];
#pragma unroll
            for (int w = 0; w < 8; ++w) s += sl[(w * NMR + r) * 64 + n];
            mod[((size_t)l * NMR + r) * NMOD + nb * 64 + n] = s; }
    }
    __syncthreads();
}

DI void p0_rope(const LA& A, int gt, int NGT) {
    float* tab = (float*)(A.W() + WS_ROPE);
    for (int i = gt; i < 4097 * 32; i += NGT) { const int pi = i >> 5, j = i & 31; const float pos = pi < 4096 ? (float)pi : 16384.f;
        const float inv = powf(10000.f, -(float)j / 32.f); const float ang = pos * inv; float s, c; sincosf(ang, &s, &c); tab[2 * i] = c; tab[2 * i + 1] = s; }
}

DI void phase_norm(const LA& A, int l, int which, int gw, int NGW, int lane) {
    const bool first = (l == 0 && which == 0);
    const float* xp = first ? A.I(0) : A.O() + O_YP;
    const float* xs = first ? A.I(1) : A.O() + O_YS;
    const float* nw = A.I(which ? 11 : 10) + (size_t)l * DM;
    const float* mod = (const float*)(A.W() + WS_MOD) + (size_t)l * NMR * NMOD + (which ? 3 : 0) * DM;
    bf16* hA = (bf16*)(A.W() + WS_HA);
    for (int row = gw; row < MT; row += NGW) {
        const float* xr = row < MP ? xp + (size_t)row * DM : xs + (size_t)(row - MP) * DM;
        const int b = row < MP ? row / SEQ : 2 + row - MP;
        const float* sh = mod + (size_t)b * NMOD; const float* sc = sh + DM;
        f32x4 v[8]; float ss = 0.f;
#pragma unroll
        for (int j = 0; j < 8; ++j) { v[j] = ((const GAS f32x4*)xr)[lane + 64 * j]; ss += (v[j].x * v[j].x + v[j].y * v[j].y) + (v[j].z * v[j].z + v[j].w * v[j].w); }
        const float rstd = 1.f / sqrtf(wave_sum(ss) * (1.f / DM) + EPS);
#pragma unroll
        for (int j = 0; j < 8; ++j) { const f32x4 w = ((const GAS f32x4*)nw)[lane + 64 * j], s = ((const GAS f32x4*)sc)[lane + 64 * j], t = ((const GAS f32x4*)sh)[lane + 64 * j];
            const f32x4 o = v[j] * rstd * w * (1.f + s) + t; v2u pk; pk.x = cvtpk(o.x, o.y); pk.y = cvtpk(o.z, o.w);
            *(GAS v2u*)(hA + (size_t)row * DM + 4 * (lane + 64 * j)) = pk; }
    }
}

namespace pg8 {
struct EpiProj {
    static constexpr bool PERM = true, AFTER_DRAIN = false;
    bf16_t* O; float* DT;
    __device__ __forceinline__ void operator()(const f32x4 (&acc)[2][2][4][2], const Unit& u, int wr, int wc, int fr, int fq) const {
        const int row0 = u.pm * BM + wr * 64 + fr;
        if (u.pn < 19) {
            const int col0 = u.pn * BM + wc * 32 + 8 * fq;
#pragma unroll
            for (int ai = 0; ai < 2; ++ai)
#pragma unroll
                for (int m = 0; m < 4; ++m) { bf16_t* rowp = O + (size_t)(row0 + ai * HALF + m * 16) * PP + col0;
#pragma unroll
                    for (int bj = 0; bj < 2; ++bj) { const f32x4 v0 = acc[ai][bj][m][0], v1 = acc[ai][bj][m][1];
                        u32x4 w; w.x = cvtpk(v0[0], v0[1]); w.y = cvtpk(v0[2], v0[3]); w.z = cvtpk(v1[0], v1[1]); w.w = cvtpk(v1[2], v1[3]);
                        *(u32x4*)(rowp + bj * HALF) = w; } }
        } else if (wc == 0 && fq < 2) {
#pragma unroll
            for (int ai = 0; ai < 2; ++ai)
#pragma unroll
                for (int m = 0; m < 4; ++m) { float* dp = DT + (size_t)(row0 + ai * HALF + m * 16) * 16 + 8 * fq;
                    *(f32x4*)dp = acc[ai][0][m][0]; *(f32x4*)(dp + 4) = acc[ai][0][m][1]; }
        }
    }
};
struct EpiResid {
    static constexpr bool PERM = false, AFTER_DRAIN = false;
    const float* xin; float* xout; const float* gate;
    __device__ __forceinline__ void operator()(const f32x4 (&acc)[2][2][4][2], const Unit& u, int wr, int wc, int fr, int fq) const {
        const int row0 = u.pm * BM + wr * 64 + fr, col0 = u.pn * BM + wc * 32 + 4 * fq;
        const float* gp = gate + (size_t)(u.pm / 16) * NMOD + col0;
        f32x4 gv[2][2];
#pragma unroll
        for (int bj = 0; bj < 2; ++bj)
#pragma unroll
            for (int n = 0; n < 2; ++n) gv[bj][n] = *(const f32x4*)(gp + bj * HALF + n * 16);
#pragma unroll
        for (int ai = 0; ai < 2; ++ai)
#pragma unroll
            for (int m = 0; m < 4; ++m) { const size_t off = (size_t)(row0 + ai * HALF + m * 16) * DM + col0;
#pragma unroll
                for (int bj = 0; bj < 2; ++bj)
#pragma unroll
                    for (int n = 0; n < 2; ++n) { const f32x4 xv = *(const f32x4*)(xin + off + bj * HALF + n * 16); *(f32x4*)(xout + off + bj * HALF + n * 16) = xv + gv[bj][n] * acc[ai][bj][m][n]; }
                asm volatile("" ::: "memory"); }
    }
};
struct EpiPlain {
    static constexpr bool PERM = true, AFTER_DRAIN = false;
    bf16_t* O; int ldc;
    __device__ __forceinline__ void operator()(const f32x4 (&acc)[2][2][4][2], const Unit& u, int wr, int wc, int fr, int fq) const {
        const int row0 = u.pm * BM + wr * 64 + fr, col0 = u.pn * BM + wc * 32 + 8 * fq;
#pragma unroll
        for (int ai = 0; ai < 2; ++ai)
#pragma unroll
            for (int m = 0; m < 4; ++m) { bf16_t* rowp = O + (size_t)(row0 + ai * HALF + m * 16) * ldc + col0;
#pragma unroll
                for (int bj = 0; bj < 2; ++bj) { const f32x4 v0 = acc[ai][bj][m][0], v1 = acc[ai][bj][m][1];
                    u32x4 w; w.x = cvtpk(v0[0], v0[1]); w.y = cvtpk(v0[2], v0[3]); w.z = cvtpk(v1[0], v1[1]); w.w = cvtpk(v1[2], v1[3]);
                    *(u32x4*)(rowp + bj * HALF) = w; } }
    }
};
}

template <class F>
DI void skinny_gemm(LAS unsigned char* lds, const bf16* As, const bf16* Bt, int N, int K, int bid, int G, int tid, int wave, int lane, F epi) {
    asm volatile("" : "+v"(tid), "+v"(lane));
    LAS float* red = (LAS float*)lds;
    const int fr = lane & 15, fq = lane >> 4, kw = K / 8;
    for (int u = bid; u < N / 16; u += G) {
        f32x4 acc0 = {0.f, 0.f, 0.f, 0.f}, acc1 = {0.f, 0.f, 0.f, 0.f};
        const bf16* bp = Bt + (size_t)(u * 16 + fr) * K + wave * kw + 8 * fq;
        const bf16* a0 = As + (size_t)fr * K + wave * kw + 8 * fq; const bf16* a1 = a0 + (size_t)16 * K;
#pragma unroll 4
        for (int k = 0; k < kw; k += 32) { const bf16x8 bv = *(const GAS bf16x8*)(bp + k), x0 = *(const GAS bf16x8*)(a0 + k), x1 = *(const GAS bf16x8*)(a1 + k);
            acc0 = MFMA16(x0, bv, acc0); acc1 = MFMA16(x1, bv, acc1); }
        *(LAS f32x4*)(red + ((wave * 2 + 0) * 64 + lane) * 4) = acc0; *(LAS f32x4*)(red + ((wave * 2 + 1) * 64 + lane) * 4) = acc1;
        __syncthreads();
        { const int col = tid & 15, row = tid >> 4, mt = row >> 4, r16 = row & 15, ln = (r16 >> 2) * 16 + col, i = r16 & 3; float s = 0.f;
#pragma unroll
          for (int w = 0; w < 8; ++w) s += red[((w * 2 + mt) * 64 + ln) * 4 + i];
          epi(row, u * 16 + col, s); }
        __syncthreads();
    }
}

constexpr int XPI = 144, SX_OFF = 8192, SB_OFF = 81920, SC_OFF = 102400, BPI1 = 320, BPI3 = 272, CPI = 272;

template <bool SCALED>
DI void ssd_stage(const LA& A, LAS unsigned char* lds, int l, int b, int c, int g, int tid, int wave, int lane) {
    LAS float* s_dt = (LAS float*)lds; LAS float* s_cs = s_dt + 512;
    constexpr int BPI = SCALED ? BPI1 : BPI3;
    {   const int hh = g * 8 + wave; const int row = b * SEQ + c * CL + lane;
        const float raw = ((const float*)(A.W() + WS_DT))[(size_t)row * 16 + hh] + A.I(17)[l * NH + hh];
        const float dt = softplus_f(raw); const float a = -expf(A.I(18)[l * NH + hh]);
        const float cs = wave_incl_scan(dt * a, lane);
        s_dt[wave * 64 + lane] = dt; s_cs[wave * 64 + lane] = cs; }
    __syncthreads();
    const int cg = tid % 96, seg = tid / 96;
    if (tid < 384 && (!SCALED || cg < 80)) {
        int col;
        if (cg < 64) col = C_X + g * 512 + cg * 8; else if (cg < 80) col = C_B + g * 128 + (cg - 64) * 8; else col = C_C + g * 128 + (cg - 80) * 8;
        const int chx = col - 1024;
        float w[4][8], bias[8];
#pragma unroll
        for (int k = 0; k < 4; ++k) { const f32x4 a0 = *(const GAS f32x4*)(A.I(15) + ((size_t)l * 4 + k) * DXBC + chx), a1 = *(const GAS f32x4*)(A.I(15) + ((size_t)l * 4 + k) * DXBC + chx + 4);
            w[k][0] = a0.x; w[k][1] = a0.y; w[k][2] = a0.z; w[k][3] = a0.w; w[k][4] = a1.x; w[k][5] = a1.y; w[k][6] = a1.z; w[k][7] = a1.w; }
        { const f32x4 a0 = *(const GAS f32x4*)(A.I(16) + (size_t)l * DXBC + chx), a1 = *(const GAS f32x4*)(A.I(16) + (size_t)l * DXBC + chx + 4);
            bias[0] = a0.x; bias[1] = a0.y; bias[2] = a0.z; bias[3] = a0.w; bias[4] = a1.x; bias[5] = a1.y; bias[6] = a1.z; bias[7] = a1.w; }
        const bf16* proj = (const bf16*)(A.W() + WS_PROJ);
        const int t0 = c * CL + seg * 16;
        float win[3][8];
#pragma unroll
        for (int j = 0; j < 3; ++j) { const int t = t0 - 3 + j;
            if (t >= 0) { const v4u v = *(const GAS v4u*)(proj + (size_t)(b * SEQ + t) * PP + col); unpack8(v, win[j]); }
            else {
#pragma unroll
                for (int e = 0; e < 8; ++e) win[j][e] = 0.f; } }
        LAS unsigned char* dst; int pitch; int head = 0;
        if (cg < 64) { head = cg >> 3; dst = lds + SX_OFF + head * 64 * XPI + (cg & 7) * 16; pitch = XPI; }
        else if (cg < 80) { dst = lds + SB_OFF + (cg - 64) * 16; pitch = BPI; }
        else { dst = lds + SC_OFF + (cg - 80) * 16; pitch = CPI; }
        const float cs_end = s_cs[head * 64 + 63];
#pragma unroll
        for (int i = 0; i < 16; ++i) {
            const int ll = seg * 16 + i;
            float cur[8], o[8];
            { const v4u v = *(const GAS v4u*)(proj + (size_t)(b * SEQ + t0 + i) * PP + col); unpack8(v, cur); }
            float scale = 1.f;
            if (SCALED && cg < 64) scale = __expf(cs_end - s_cs[head * 64 + ll]) * s_dt[head * 64 + ll];
#pragma unroll
            for (int e = 0; e < 8; ++e) { const float y = bias[e] + w[0][e] * win[0][e] + w[1][e] * win[1][e] + w[2][e] * win[2][e] + w[3][e] * cur[e]; o[e] = silu_f(y) * scale;
                win[0][e] = win[1][e]; win[1][e] = win[2][e]; win[2][e] = cur[e]; }
            *(LAS v4u*)(dst + ll * pitch) = pack8(o);
        }
    }
    __syncthreads();
}

DI void ssd_chunk_state(const LA& A, LAS unsigned char* lds, int l, int u, int tid, int wave, int lane) {
    const int b = u >> 7, c = (u >> 1) & 63, g = u & 1;
    ssd_stage<true>(A, lds, l, b, c, g, tid, wave, lane);
    const int r = lane & 31, h = lane >> 5, blk = (lane >> 4) & 1, q = (lane & 15) >> 2, p4 = lane & 3;
    const LAS unsigned char* xb = lds + SX_OFF + wave * 64 * XPI + 32 * blk + 8 * p4;
    const LAS unsigned char* bb = lds + SB_OFF + 32 * blk + 8 * p4;
    f32x16 acc[4][2];
#pragma unroll
    for (int nt = 0; nt < 4; ++nt) { acc[nt][0] = zero16(); acc[nt][1] = zero16(); }
#pragma unroll
    for (int ks = 0; ks < 4; ++ks) {
        const int row0 = 16 * ks + 8 * h + q;
        bf16x8 af[4], bf[2];
#pragma unroll
        for (int nt = 0; nt < 4; ++nt) af[nt] = tr_pair(bb + row0 * BPI1 + nt * 64, bb + (row0 + 4) * BPI1 + nt * 64);
#pragma unroll
        for (int pt = 0; pt < 2; ++pt) bf[pt] = tr_pair(xb + row0 * XPI + pt * 64, xb + (row0 + 4) * XPI + pt * 64);
#pragma unroll
        for (int nt = 0; nt < 4; ++nt) { acc[nt][0] = MFMA32(af[nt], bf[0], acc[nt][0]); acc[nt][1] = MFMA32(af[nt], bf[1], acc[nt][1]); }
    }
    const int hh = g * 8 + wave;
    bf16* st = (bf16*)(A.W() + WS_ST) + ((size_t)((b * NCH + c) * NH + hh) * HP) * DST;
#pragma unroll
    for (int nt = 0; nt < 4; ++nt)
#pragma unroll
        for (int pt = 0; pt < 2; ++pt)
#pragma unroll
            for (int gq = 0; gq < 4; ++gq) { v2u pk; pk.x = cvtpk(acc[nt][pt][4 * gq], acc[nt][pt][4 * gq + 1]); pk.y = cvtpk(acc[nt][pt][4 * gq + 2], acc[nt][pt][4 * gq + 3]);
                *(GAS v2u*)(st + (size_t)(32 * pt + r) * DST + 32 * nt + 8 * gq + 4 * h) = pk; }
    if (lane == 0) ((float*)(A.W() + WS_DECAY))[(b * NCH + c) * NH + hh] = __expf(((LAS float*)lds)[512 + wave * 64 + 63]);
    __syncthreads();
}

DI void ssd_scan(const LA& A, int l, int bid, int G, int tid) {
    unsigned* st = (unsigned*)(A.W() + WS_ST); const float* dec = (const float*)(A.W() + WS_DECAY);
    for (int e = bid * NT + tid; e < NBP * NH * HP * (DST / 2); e += G * NT) {
        const int np = e & 63, p = (e >> 6) & 63, hh = (e >> 12) & 15, b = e >> 16;
        size_t idx = ((size_t)(b * NCH) * NH + hh) * (HP * DST / 2) + p * (DST / 2) + np;
        float h0 = 0.f, h1 = 0.f;
#pragma unroll 8
        for (int c = 0; c < NCH; ++c) { const unsigned s = st[idx]; const float d = dec[(b * NCH + c) * NH + hh]; st[idx] = cvtpk(h0, h1);
            h0 = d * h0 + bflo(s); h1 = d * h1 + bfhi(s); idx += (size_t)NH * (HP * DST / 2); }
        f32x2_t o = {h0, h1};
        *(GAS f32x2_t*)(A.O() + O_PSSM + ((size_t)((l * NBP + b) * NH + hh) * HP + p) * DST + 2 * np) = o;
    }
}

DI void ssd_chunk_out(const LA& A, LAS unsigned char* lds, int l, int u, int tid, int wave, int lane) {
    const int b = u >> 7, c = (u >> 1) & 63, g = u & 1;
    ssd_stage<false>(A, lds, l, b, c, g, tid, wave, lane);
    LAS float* s_dt = (LAS float*)lds; LAS float* s_cs = s_dt + 512; LAS float* s_ss = s_dt + 1024;
    const int r = lane & 31, h = lane >> 5, blk = (lane >> 4) & 1, q = (lane & 15) >> 2, p4 = lane & 3;
    const int hh = g * 8 + wave;
    const LAS unsigned char* bimg = lds + SB_OFF; const LAS unsigned char* cimg = lds + SC_OFF;
    const bf16* hs = (const bf16*)(A.W() + WS_ST) + ((size_t)((b * NCH + c) * NH + hh) * HP) * DST;
    f32x16 X0 = zero16(), X1 = zero16(), X2 = zero16(), Y00 = zero16(), Y01 = zero16(), Y10 = zero16(), Y11 = zero16();
#pragma unroll
    for (int ks = 0; ks < 8; ++ks) {
        const int ko = (16 * ks + 8 * h) * 2;
        const bf16x8 bs0 = *(const LAS bf16x8*)(bimg + r * BPI3 + ko), bs1 = *(const LAS bf16x8*)(bimg + (32 + r) * BPI3 + ko);
        const bf16x8 cl0 = *(const LAS bf16x8*)(cimg + r * CPI + ko), cl1 = *(const LAS bf16x8*)(cimg + (32 + r) * CPI + ko);
        const bf16x8 ha0 = *(const GAS bf16x8*)(hs + (size_t)r * DST + 16 * ks + 8 * h), ha1 = *(const GAS bf16x8*)(hs + (size_t)(32 + r) * DST + 16 * ks + 8 * h);
        X0 = MFMA32(bs0, cl0, X0); X1 = MFMA32(bs0, cl1, X1); X2 = MFMA32(bs1, cl1, X2);
        Y00 = MFMA32(ha0, cl0, Y00); Y01 = MFMA32(ha0, cl1, Y01); Y10 = MFMA32(ha1, cl0, Y10); Y11 = MFMA32(ha1, cl1, Y11);
        if (ks & 1) __builtin_amdgcn_sched_barrier(0);
    }
    const float csl0 = s_cs[wave * 64 + r], csl1 = s_cs[wave * 64 + 32 + r];
    { const float e0 = __expf(csl0), e1 = __expf(csl1);
#pragma unroll
      for (int i = 0; i < 16; ++i) { Y00[i] *= e0; Y10[i] *= e0; Y01[i] *= e1; Y11[i] *= e1; } }
#pragma unroll
    for (int gq = 0; gq < 4; ++gq) {
        const f32x4 csa = *(const LAS f32x4*)(s_cs + wave * 64 + 8 * gq + 4 * h), dta = *(const LAS f32x4*)(s_dt + wave * 64 + 8 * gq + 4 * h);
        const f32x4 csb = *(const LAS f32x4*)(s_cs + wave * 64 + 32 + 8 * gq + 4 * h), dtb = *(const LAS f32x4*)(s_dt + wave * 64 + 32 + 8 * gq + 4 * h);
#pragma unroll
        for (int e = 0; e < 4; ++e) { const int i = 4 * gq + e; const int s = 8 * gq + 4 * h + e;
            const float w0 = __expf(fminf(csl0 - csa[e], 0.f)) * dta[e], w1 = __expf(fminf(csl1 - csa[e], 0.f)) * dta[e], w2 = __expf(fminf(csl1 - csb[e], 0.f)) * dtb[e];
            X0[i] = (s <= r) ? X0[i] * w0 : 0.f; X1[i] = X1[i] * w1; X2[i] = (s <= r) ? X2[i] * w2 : 0.f; }
    }
    {   const LAS unsigned char* xb = lds + SX_OFF + wave * 64 * XPI + 32 * blk + 8 * p4;
#pragma unroll
        for (int ks2 = 0; ks2 < 2; ++ks2) {
            const bf16x8 W0 = pack_frag(X0, ks2), W1 = pack_frag(X1, ks2), W2 = pack_frag(X2, ks2);
            const int ra = 16 * ks2 + 4 * h + q, rb = 32 + 16 * ks2 + 4 * h + q;
            const bf16x8 xa0 = tr_pair(xb + ra * XPI, xb + (ra + 8) * XPI), xa1 = tr_pair(xb + ra * XPI + 64, xb + (ra + 8) * XPI + 64);
            const bf16x8 xc0 = tr_pair(xb + rb * XPI, xb + (rb + 8) * XPI), xc1 = tr_pair(xb + rb * XPI + 64, xb + (rb + 8) * XPI + 64);
            Y00 = MFMA32(xa0, W0, Y00); Y10 = MFMA32(xa1, W0, Y10);
            Y01 = MFMA32(xa0, W1, Y01); Y11 = MFMA32(xa1, W1, Y11);
            Y01 = MFMA32(xc0, W2, Y01); Y11 = MFMA32(xc1, W2, Y11);
        }
    }
    const float Dk = A.I(19)[l * NH + hh];
    const bf16* proj = (const bf16*)(A.W() + WS_PROJ);
    const LAS unsigned char* xrow = lds + SX_OFF + wave * 64 * XPI;
    float ss0 = 0.f, ss1 = 0.f;
#define SSD_EPI1(Y, pt, lt, ssv) do { const size_t zoff = (size_t)(b * SEQ + c * CL + 32 * (lt) + r) * PP + C_Z + hh * 64; \
        _Pragma("unroll") for (int gq = 0; gq < 4; ++gq) { const int p0 = 32 * (pt) + 8 * gq + 4 * h; \
            float xv[4], zv[4]; unpack4(*(const LAS v2u*)(xrow + (32 * (lt) + r) * XPI + p0 * 2), xv); unpack4(*(const GAS v2u*)(proj + zoff + p0), zv); \
            _Pragma("unroll") for (int e = 0; e < 4; ++e) { const float y = (Y[4 * gq + e] + Dk * xv[e]) * silu_f(zv[e]); Y[4 * gq + e] = y; ssv += y * y; } } } while (0)
    SSD_EPI1(Y00, 0, 0, ss0); SSD_EPI1(Y10, 1, 0, ss0); SSD_EPI1(Y01, 0, 1, ss1); SSD_EPI1(Y11, 1, 1, ss1);
#undef SSD_EPI1
    ss0 += __shfl_xor(ss0, 32); ss1 += __shfl_xor(ss1, 32);
    if (h == 0) { s_ss[wave * 64 + r] = ss0; s_ss[wave * 64 + 32 + r] = ss1; }
    __syncthreads();
    float t0 = 0.f, t1 = 0.f;
#pragma unroll
    for (int w = 0; w < 8; ++w) { t0 += s_ss[w * 64 + r]; t1 += s_ss[w * 64 + 32 + r]; }
    const float rs0 = 1.f / sqrtf(t0 * (1.f / 512.f) + EPS), rs1 = 1.f / sqrtf(t1 * (1.f / 512.f) + EPS);
    const float* nw = A.I(20) + (size_t)l * DSSD + hh * 64;
    bf16* mix = (bf16*)(A.W() + WS_MIX);
#define SSD_EPI2(Y, pt, lt, rs) do { bf16* op = mix + (size_t)(b * SEQ + c * CL + 32 * (lt) + r) * DM + hh * 64; \
        _Pragma("unroll") for (int gq = 0; gq < 4; ++gq) { const int p0 = 32 * (pt) + 8 * gq + 4 * h; const f32x4 wv = *(const GAS f32x4*)(nw + p0); \
            v2u pk; pk.x = cvtpk(Y[4 * gq] * rs * wv.x, Y[4 * gq + 1] * rs * wv.y); pk.y = cvtpk(Y[4 * gq + 2] * rs * wv.z, Y[4 * gq + 3] * rs * wv.w); *(GAS v2u*)(op + p0) = pk; } } while (0)
    SSD_EPI2(Y00, 0, 0, rs0); SSD_EPI2(Y10, 1, 0, rs0); SSD_EPI2(Y01, 0, 1, rs1); SSD_EPI2(Y11, 1, 1, rs1);
#undef SSD_EPI2
    __syncthreads();
}

constexpr int KPI = 144, VPI = 192, AK_OFF = 0, AV_OFF = 36864;
DI void attn_unit(const LA& A, LAS unsigned char* lds, int l, int u, int tid, int wave, int lane) {
    const int b = u >> 6, blk = (u >> 1) & 31, kvh = u & 1;
    const bf16* proj = (const bf16*)(A.W() + WS_PROJ);
    const float* rope = (const float*)(A.W() + WS_ROPE);
    {
        const int sub = tid & 7; const float* knw = A.I(22) + (size_t)l * HD;
        const f32x4 wlo = *(const GAS f32x4*)(knw + 4 * sub), whi = *(const GAS f32x4*)(knw + 32 + 4 * sub);
#pragma unroll
        for (int it = 0; it < 4; ++it) { const int j = it * 64 + (tid >> 3); const int t = (blk - 1) * 128 + j;
            float lo[4] = {0.f, 0.f, 0.f, 0.f}, hi[4] = {0.f, 0.f, 0.f, 0.f}; f32x4 cs0 = {1.f, 0.f, 1.f, 0.f}, cs1 = cs0;
            if (t >= 0) { const bf16* kp = proj + (size_t)(b * SEQ + t) * PP + C_K + kvh * 64 + 4 * sub; unpack4(*(const GAS v2u*)kp, lo); unpack4(*(const GAS v2u*)(kp + 32), hi);
                cs0 = *(const GAS f32x4*)(rope + ((size_t)t * 32 + 4 * sub) * 2); cs1 = *(const GAS f32x4*)(rope + ((size_t)t * 32 + 4 * sub) * 2 + 4); }
            float ss = (lo[0] * lo[0] + lo[1] * lo[1]) + (lo[2] * lo[2] + lo[3] * lo[3]) + (hi[0] * hi[0] + hi[1] * hi[1]) + (hi[2] * hi[2] + hi[3] * hi[3]);
            ss += __shfl_xor(ss, 1); ss += __shfl_xor(ss, 2); ss += __shfl_xor(ss, 4);
            const float rstd = 1.f / sqrtf(ss * (1.f / 64.f) + EPS);
            const float cc[4] = {cs0.x, cs0.z, cs1.x, cs1.z}, sn[4] = {cs0.y, cs0.w, cs1.y, cs1.w}; const float wl[4] = {wlo.x, wlo.y, wlo.z, wlo.w}, wh[4] = {whi.x, whi.y, whi.z, whi.w};
            float ol[4], oh[4];
#pragma unroll
            for (int e = 0; e < 4; ++e) { const float a = lo[e] * rstd * wl[e], bb = hi[e] * rstd * wh[e]; ol[e] = a * cc[e] - bb * sn[e]; oh[e] = bb * cc[e] + a * sn[e]; }
            v2u pl, ph; pl.x = cvtpk(ol[0], ol[1]); pl.y = cvtpk(ol[2], ol[3]); ph.x = cvtpk(oh[0], oh[1]); ph.y = cvtpk(oh[2], oh[3]);
            *(LAS v2u*)(lds + AK_OFF + j * KPI + 8 * sub) = pl; *(LAS v2u*)(lds + AK_OFF + j * KPI + 64 + 8 * sub) = ph;
            if (blk == 31 && j >= 128) { float* o = A.O() + O_PWK + ((size_t)((l * NBP + b) * WIN + (j - 128)) * NKV + kvh) * HD;
                f32x4 v0 = {ol[0], ol[1], ol[2], ol[3]}, v1 = {oh[0], oh[1], oh[2], oh[3]}; *(GAS f32x4*)(o + 4 * sub) = v0; *(GAS f32x4*)(o + 32 + 4 * sub) = v1; }
        }
#pragma unroll
        for (int it = 0; it < 4; ++it) { const int idx = tid + NT * it; const int j = idx >> 3, ch = idx & 7; const int t = (blk - 1) * 128 + j;
            v4u v = {0u, 0u, 0u, 0u};
            if (t >= 0) v = *(const GAS v4u*)(proj + (size_t)(b * SEQ + t) * PP + C_V + kvh * 64 + 8 * ch);
            *(LAS v4u*)(lds + AV_OFF + j * VPI + 16 * ch) = v;
            if (blk == 31 && j >= 128) { float f[8]; unpack8(v, f); float* o = A.O() + O_PWV + ((size_t)((l * NBP + b) * WIN + (j - 128)) * NKV + kvh) * HD + 8 * ch;
                f32x4 v0 = {f[0], f[1], f[2], f[3]}, v1 = {f[4], f[5], f[6], f[7]}; *(GAS f32x4*)o = v0; *(GAS f32x4*)(o + 4) = v1; }
        }
    }
    __syncthreads();
    const int r = lane & 31, h = lane >> 5, blkl = (lane >> 4) & 1, q = (lane & 15) >> 2, p4 = lane & 3;
    const int qh = wave >> 1, half = wave & 1, head = kvh * 4 + qh;
    const float sink = A.I(23)[l * NQH + head];
    const float* qnw = A.I(21) + (size_t)l * HD;
    bf16* mix = (bf16*)(A.W() + WS_MIX);
#pragma unroll 1
    for (int tt = 0; tt < 2; ++tt) {
        const int tq = 2 * half + tt; const int tok = blk * 128 + 32 * tq + r; const size_t row = (size_t)b * SEQ + tok;
        float qf[4][8]; float ss = 0.f;
#pragma unroll
        for (int ks = 0; ks < 4; ++ks) { unpack8(*(const GAS v4u*)(proj + row * PP + C_Q + head * 64 + 16 * ks + 8 * h), qf[ks]);
#pragma unroll
            for (int e = 0; e < 8; ++e) ss += qf[ks][e] * qf[ks][e]; }
        ss += __shfl_xor(ss, 32);
        const float rstd = 0.125f / sqrtf(ss * (1.f / 64.f) + EPS);
        bf16x8 qb[4];
        {   float o[4][8];
#pragma unroll
            for (int ks = 0; ks < 2; ++ks) {
#pragma unroll
                for (int e = 0; e < 8; ++e) { const int d = 16 * ks + 8 * h + e; const f32x2_t cs = *(const GAS f32x2_t*)(rope + ((size_t)tok * 32 + d) * 2);
                    const float a = qf[ks][e] * rstd * qnw[d], bb = qf[ks + 2][e] * rstd * qnw[d + 32]; o[ks][e] = a * cs.x - bb * cs.y; o[ks + 2][e] = bb * cs.x + a * cs.y; } }
#pragma unroll
            for (int ks = 0; ks < 4; ++ks) qb[ks] = __builtin_bit_cast(bf16x8, pack8(o[ks]));
        }
        f32x16 S[5];
#pragma unroll
        for (int jj = 0; jj < 5; ++jj) { S[jj] = zero16();
#pragma unroll
            for (int ks = 0; ks < 4; ++ks) { const bf16x8 ka = *(const LAS bf16x8*)(lds + AK_OFF + (32 * (tq + jj) + r) * KPI + (16 * ks + 8 * h) * 2); S[jj] = MFMA32(ka, qb[ks], S[jj]); }
            __builtin_amdgcn_sched_barrier(0); }
        float m = sink;
#pragma unroll
        for (int jj = 0; jj < 5; ++jj)
#pragma unroll
            for (int i = 0; i < 16; ++i) { const int dj = 32 * jj + crow(i, h) - r; const bool ok = dj >= 0 && dj <= WIN && (blk > 0 || 32 * (tq + jj) >= 128);
                S[jj][i] = ok ? S[jj][i] : -1e30f; m = fmaxf(m, S[jj][i]); }
        m = fmaxf(m, __shfl_xor(m, 32));
        float sum = 0.f;
#pragma unroll
        for (int jj = 0; jj < 5; ++jj)
#pragma unroll
            for (int i = 0; i < 16; ++i) { const float p = __expf(S[jj][i] - m); S[jj][i] = p; sum += p; }
        sum += __shfl_xor(sum, 32);
        const float inv = 1.f / (sum + __expf(sink - m));
        __builtin_amdgcn_sched_barrier(0);
        f32x16 O0 = zero16(), O1 = zero16();
        const LAS unsigned char* vb = lds + AV_OFF + 32 * blkl + 8 * p4;
#pragma unroll
        for (int jj = 0; jj < 5; ++jj)
#pragma unroll
            for (int ks2 = 0; ks2 < 2; ++ks2) { const bf16x8 pb = pack_frag(S[jj], ks2); const int jr = 32 * (tq + jj) + 16 * ks2 + 4 * h + q;
                const bf16x8 va0 = tr_pair(vb + jr * VPI, vb + (jr + 8) * VPI), va1 = tr_pair(vb + jr * VPI + 64, vb + (jr + 8) * VPI + 64);
                O0 = MFMA32(va0, pb, O0); O1 = MFMA32(va1, pb, O1); __builtin_amdgcn_sched_barrier(0); }
        bf16* op = mix + row * DM + DSSD + head * 64;
#pragma unroll
        for (int gq = 0; gq < 4; ++gq) { v2u pk; pk.x = cvtpk(O0[4 * gq] * inv, O0[4 * gq + 1] * inv); pk.y = cvtpk(O0[4 * gq + 2] * inv, O0[4 * gq + 3] * inv); *(GAS v2u*)(op + 8 * gq + 4 * h) = pk;
            pk.x = cvtpk(O1[4 * gq] * inv, O1[4 * gq + 1] * inv); pk.y = cvtpk(O1[4 * gq + 2] * inv, O1[4 * gq + 3] * inv); *(GAS v2u*)(op + 32 + 8 * gq + 4 * h) = pk; }
    }
    __syncthreads();
}

DI void samp_ssd_unit(const LA& A, LAS unsigned char* lds, int l, int u, int tid, int wave, int lane) {
    const int sb = u >> 1, g = u & 1;
    LAS float* xs = (LAS float*)lds; LAS float* Bv = xs + 512; LAS float* Cv = Bv + 128; LAS float* s_ss = Cv + 128;
    const float* ps = (const float*)(A.W() + WS_PROJS) + (size_t)sb * PSP;
    for (int ci = tid; ci < 768; ci += NT) {
        const int chx = ci < 512 ? g * 512 + ci : (ci < 640 ? 1024 + g * 128 + (ci - 512) : 1280 + g * 128 + (ci - 640));
        const float nr = ps[1024 + chx];
        const float* sp = A.I(3) + ((size_t)(l * MS + sb) * 3) * DXBC + chx;
        const float p0 = sp[0], p1 = sp[DXBC], p2 = sp[2 * DXBC];
        const float* cw = A.I(15) + (size_t)l * 4 * DXBC + chx;
        const float v = silu_f(A.I(16)[(size_t)l * DXBC + chx] + cw[0] * p0 + cw[DXBC] * p1 + cw[2 * DXBC] * p2 + cw[3 * DXBC] * nr);
        float* so = A.O() + O_SSSMCONV + ((size_t)(l * MS + sb) * 3) * DXBC + chx;
        so[0] = p1; so[DXBC] = p2; so[2 * DXBC] = nr;
        xs[ci] = v;
    }
    __syncthreads();
    const int hh = g * 8 + wave;
    const float dt = softplus_f(ps[C_DT + hh] + A.I(17)[l * NH + hh]);
    const float dA = expf(dt * -expf(A.I(18)[l * NH + hh]));
    const float Dk = A.I(19)[l * NH + hh];
    const size_t hoff = ((size_t)((l * MS + sb) * NH + hh) * HP) * DST;
    const float* h0 = A.I(2) + hoff; float* ho = A.O() + O_SSSM + hoff;
    const float b0 = Bv[2 * lane], b1 = Bv[2 * lane + 1], c0 = Cv[2 * lane], c1 = Cv[2 * lane + 1];
    float ymine = 0.f;
#pragma unroll 4
    for (int p = 0; p < HP; ++p) { const float xp = xs[wave * 64 + p]; const f32x2_t hv = *(const GAS f32x2_t*)(h0 + p * DST + 2 * lane);
        f32x2_t hn; hn.x = dA * hv.x + dt * xp * b0; hn.y = dA * hv.y + dt * xp * b1; *(GAS f32x2_t*)(ho + p * DST + 2 * lane) = hn;
        const float part = wave_sum(c0 * hn.x + c1 * hn.y); if (lane == p) ymine = part + Dk * xp; }
    const float y = ymine * silu_f(ps[C_Z + hh * 64 + lane]);
    const float ssq = wave_sum(y * y);
    if (lane == 0) s_ss[wave] = ssq;
    __syncthreads();
    float tot = 0.f;
#pragma unroll
    for (int w = 0; w < 8; ++w) tot += s_ss[w];
    const float rstd = 1.f / sqrtf(tot * (1.f / 512.f) + EPS);
    const float o = y * rstd * A.I(20)[(size_t)l * DSSD + hh * 64 + lane];
    ((bf16*)(A.W() + WS_MIX))[(size_t)(MP + sb) * DM + hh * 64 + lane] = (bf16)(cvtpk(o, 0.f) & 0xffffu);
    __syncthreads();
}

DI void samp_attn_unit(const LA& A, LAS unsigned char* lds, int l, int u, int tid, int wave, int lane) {
    const int sb = u >> 1, kvh = u & 1;
    LAS float* s_q = (LAS float*)lds;
    LAS float* s_k = s_q + 256;
    LAS float* s_v = s_k + 64;
    LAS float* s_p = s_v + 64;
    const float* ps = (const float*)(A.W() + WS_PROJS) + (size_t)sb * PSP;
    const float* rope = (const float*)(A.W() + WS_ROPE) + (size_t)4096 * 64;
    if (wave < 5) {
        const int col = wave < 4 ? C_Q + (kvh * 4 + wave) * 64 : C_K + kvh * 64;
        const float x = ps[col + lane];
        const float rstd = 1.f / sqrtf(wave_sum(x * x) * (1.f / 64.f) + EPS);
        const float w = (wave < 4 ? A.I(21) : A.I(22))[(size_t)l * HD + lane];
        const float xn = x * rstd * w; const float other = __shfl_xor(xn, 32);
        const int i = lane & 31; const float cs = rope[2 * i], sn = rope[2 * i + 1];
        const float o = lane < 32 ? xn * cs - other * sn : xn * cs + other * sn;
        if (wave < 4) s_q[wave * 64 + lane] = o * 0.125f; else s_k[lane] = o;
    } else if (wave == 5) s_v[lane] = ps[C_V + kvh * 64 + lane];
    __syncthreads();
    const float* kc = A.I(4) + ((size_t)(l * MS + sb) * WIN) * (NKV * HD) + kvh * HD;
    const float* vc = A.I(5) + ((size_t)(l * MS + sb) * WIN) * (NKV * HD) + kvh * HD;
    if (wave < 4) {
        const int head = kvh * 4 + wave; const float sink = A.I(23)[l * NQH + head];
        float s0 = 0.f, s1 = 0.f, s2 = 0.f;
        const float* k0 = kc + (size_t)lane * (NKV * HD); const float* k1 = kc + (size_t)(lane + 64) * (NKV * HD);
#pragma unroll
        for (int d4 = 0; d4 < 16; ++d4) { const f32x4 qv = *(const LAS f32x4*)(s_q + wave * 64 + 4 * d4); const f32x4 a = *(const GAS f32x4*)(k0 + 4 * d4), bq = *(const GAS f32x4*)(k1 + 4 * d4); const f32x4 kn = *(const LAS f32x4*)(s_k + 4 * d4);
            s0 += (qv.x * a.x + qv.y * a.y) + (qv.z * a.z + qv.w * a.w); s1 += (qv.x * bq.x + qv.y * bq.y) + (qv.z * bq.z + qv.w * bq.w); s2 += (qv.x * kn.x + qv.y * kn.y) + (qv.z * kn.z + qv.w * kn.w); }
        float m = fmaxf(fmaxf(s0, s1), fmaxf(s2, sink)); m = wave_max(m);
        const float p0 = __expf(s0 - m), p1 = __expf(s1 - m), p2 = __expf(s2 - m);
        const float den = wave_sum(p0 + p1) + p2 + __expf(sink - m);
        const float inv = 1.f / den;
        s_p[wave * 132 + lane] = p0 * inv; s_p[wave * 132 + 64 + lane] = p1 * inv; if (lane == 0) s_p[wave * 132 + 128] = p2 * inv;
        LDS_WAIT(); asm volatile("" ::: "memory");
        float o = s_p[wave * 132 + 128] * s_v[lane];
#pragma unroll 8
        for (int j = 0; j < WIN; ++j) o += s_p[wave * 132 + j] * vc[(size_t)j * (NKV * HD) + lane];
        ((bf16*)(A.W() + WS_MIX))[(size_t)(MP + sb) * DM + DSSD + head * 64 + lane] = (bf16)(cvtpk(o, 0.f) & 0xffffu);
    } else {
        float* ok = A.O() + O_SWK + ((size_t)(l * MS + sb) * WIN) * (NKV * HD) + kvh * HD;
        float* ov = A.O() + O_SWV + ((size_t)(l * MS + sb) * WIN) * (NKV * HD) + kvh * HD;
        for (int j = wave - 4; j < WIN; j += 4) {
            const float kv = j < WIN - 1 ? kc[(size_t)(j + 1) * (NKV * HD) + lane] : s_k[lane];
            const float vv = j < WIN - 1 ? vc[(size_t)(j + 1) * (NKV * HD) + lane] : s_v[lane];
            ok[(size_t)j * (NKV * HD) + lane] = kv; ov[(size_t)j * (NKV * HD) + lane] = vv; }
    }
    __syncthreads();
}

DI void samp_sconv_unit(const LA& A, int l, int u, int tid) {
    for (int i = tid; i < 4 * DCONV; i += NT) { const int sb = u * 4 + (i >> 9), ch = i & 511;
        const float* ps = (const float*)(A.W() + WS_PROJS) + (size_t)sb * PSP;
        const float vn = ps[C_GC + ch] * ps[C_HC + ch];
        const float* sp = A.I(6) + ((size_t)(l * MS + sb) * 2) * DCONV + ch; const float p0 = sp[0], p1 = sp[DCONV];
        const float* cw = A.I(24) + (size_t)l * 3 * DCONV + ch;
        const float y = ps[C_GB + ch] * (cw[0] * p0 + cw[DCONV] * p1 + cw[2 * DCONV] * vn);
        ((bf16*)(A.W() + WS_MIX))[(size_t)(MP + sb) * DM + 1536 + ch] = (bf16)(cvtpk(y, 0.f) & 0xffffu);
        float* so = A.O() + O_SSC + ((size_t)(l * MS + sb) * 2) * DCONV + ch; so[0] = p1; so[DCONV] = vn; }
}

DI void sconv_unit(const LA& A, int l, int u, int tid) {
    const int b = u >> 6, tile = u & 63, cg = tid & 63, seg = tid >> 6;
    const bf16* proj = (const bf16*)(A.W() + WS_PROJ); bf16* mix = (bf16*)(A.W() + WS_MIX);
    const int t0 = tile * 64 + seg * 8, ch = cg * 8;
    float w[3][8];
#pragma unroll
    for (int k = 0; k < 3; ++k) { const f32x4 a0 = *(const GAS f32x4*)(A.I(24) + ((size_t)l * 3 + k) * DCONV + ch), a1 = *(const GAS f32x4*)(A.I(24) + ((size_t)l * 3 + k) * DCONV + ch + 4);
        w[k][0] = a0.x; w[k][1] = a0.y; w[k][2] = a0.z; w[k][3] = a0.w; w[k][4] = a1.x; w[k][5] = a1.y; w[k][6] = a1.z; w[k][7] = a1.w; }
    float win[2][8];
#pragma unroll
    for (int j = 0; j < 2; ++j) { const int t = t0 - 2 + j;
        if (t >= 0) { float gc[8], hc[8]; const bf16* rp = proj + (size_t)(b * SEQ + t) * PP; unpack8(*(const GAS v4u*)(rp + C_GC + ch), gc); unpack8(*(const GAS v4u*)(rp + C_HC + ch), hc);
#pragma unroll
            for (int e = 0; e < 8; ++e) win[j][e] = gc[e] * hc[e]; }
        else {
#pragma unroll
            for (int e = 0; e < 8; ++e) win[j][e] = 0.f; } }
#pragma unroll
    for (int i = 0; i < 8; ++i) { const int t = t0 + i; const bf16* rp = proj + (size_t)(b * SEQ + t) * PP;
        float gc[8], hc[8], gb[8], o[8]; unpack8(*(const GAS v4u*)(rp + C_GC + ch), gc); unpack8(*(const GAS v4u*)(rp + C_HC + ch), hc); unpack8(*(const GAS v4u*)(rp + C_GB + ch), gb);
#pragma unroll
        for (int e = 0; e < 8; ++e) { const float v = gc[e] * hc[e]; o[e] = gb[e] * (w[0][e] * win[0][e] + w[1][e] * win[1][e] + w[2][e] * v); win[0][e] = win[1][e]; win[1][e] = v; }
        *(GAS v4u*)(mix + (size_t)(b * SEQ + t) * DM + 1536 + ch) = pack8(o); }
    if (tile == 63 && seg == 7) { float* so = A.O() + O_PSC + ((size_t)(l * NBP + b) * 2) * DCONV + ch;
#pragma unroll
        for (int e = 0; e < 8; ++e) { so[e] = win[0][e]; so[DCONV + e] = win[1][e]; } }
    if (tile == 63) { float* so = A.O() + O_PSSMCONV + ((size_t)(l * NBP + b) * 3) * DXBC;
        for (int i = tid; i < 3 * DXBC; i += NT) { const int rr = i / DXBC, cx = i % DXBC; const unsigned short v = proj[(size_t)(b * SEQ + SEQ - 3 + rr) * PP + 1024 + cx]; so[i] = __uint_as_float((unsigned)v << 16); } }
}

DI void act_unit(const LA& A, int l, int u, int tid) {
    const int cb = u % 11, tile = (u / 11) & 63, b = u / (11 * 64), cg = tid & 63, seg = tid >> 6;
    const bf16* gu = (const bf16*)(A.W() + WS_GU); bf16* act = (bf16*)(A.W() + WS_ACT);
    const int t0 = tile * 64 + seg * 8, ch = cb * 512 + cg * 8;
    float w[3][8], bias[8];
#pragma unroll
    for (int k = 0; k < 3; ++k) { const f32x4 a0 = *(const GAS f32x4*)(A.I(27) + ((size_t)l * 3 + k) * DFF + ch), a1 = *(const GAS f32x4*)(A.I(27) + ((size_t)l * 3 + k) * DFF + ch + 4);
        w[k][0] = a0.x; w[k][1] = a0.y; w[k][2] = a0.z; w[k][3] = a0.w; w[k][4] = a1.x; w[k][5] = a1.y; w[k][6] = a1.z; w[k][7] = a1.w; }
    { const f32x4 a0 = *(const GAS f32x4*)(A.I(28) + (size_t)l * DFF + ch), a1 = *(const GAS f32x4*)(A.I(28) + (size_t)l * DFF + ch + 4);
        bias[0] = a0.x; bias[1] = a0.y; bias[2] = a0.z; bias[3] = a0.w; bias[4] = a1.x; bias[5] = a1.y; bias[6] = a1.z; bias[7] = a1.w; }
    float win[2][8];
#pragma unroll
    for (int j = 0; j < 2; ++j) { const int t = t0 - 2 + j;
        if (t >= 0) unpack8(*(const GAS v4u*)(gu + (size_t)(b * SEQ + t) * (2 * DFF) + ch), win[j]);
        else {
#pragma unroll
            for (int e = 0; e < 8; ++e) win[j][e] = 0.f; } }
#pragma unroll
    for (int i = 0; i < 8; ++i) { const int t = t0 + i; const bf16* rp = gu + (size_t)(b * SEQ + t) * (2 * DFF) + ch;
        float gt[8], uu[8], o[8]; unpack8(*(const GAS v4u*)rp, gt); unpack8(*(const GAS v4u*)(rp + DFF), uu);
#pragma unroll
        for (int e = 0; e < 8; ++e) { o[e] = silu_f(bias[e] + w[0][e] * win[0][e] + w[1][e] * win[1][e] + w[2][e] * gt[e]) * uu[e]; win[0][e] = win[1][e]; win[1][e] = gt[e]; }
        *(GAS v4u*)(act + (size_t)(b * SEQ + t) * DFF + ch) = pack8(o); }
    if (tile == 63 && seg == 7) { float* so = A.O() + O_PFC + ((size_t)(l * NBP + b) * 2) * DFF + ch;
#pragma unroll
        for (int e = 0; e < 8; ++e) { so[e] = win[0][e]; so[DFF + e] = win[1][e]; } }
}
DI void samp_act_unit(const LA& A, int l, int sb, int tid) {
    const float* gs = (const float*)(A.W() + WS_GUS) + (size_t)sb * (2 * DFF);
    for (int j = tid; j < DFF; j += NT) { const float gn = gs[j], un = gs[DFF + j];
        const float* sp = A.I(7) + ((size_t)(l * MS + sb) * 2) * DFF + j; const float p0 = sp[0], p1 = sp[DFF];
        const float* cw = A.I(27) + (size_t)l * 3 * DFF + j;
        const float o = silu_f(A.I(28)[(size_t)l * DFF + j] + cw[0] * p0 + cw[DFF] * p1 + cw[2 * DFF] * gn) * un;
        ((bf16*)(A.W() + WS_ACT))[(size_t)(MP + sb) * DFF + j] = (bf16)(cvtpk(o, 0.f) & 0xffffu);
        float* so = A.O() + O_SFC + ((size_t)(l * MS + sb) * 2) * DFF + j; so[0] = p1; so[DFF] = gn; }
}

#ifndef PHMASK
#define PHMASK 0xffffffffu
#endif
#define EN(k) ((((unsigned)(PHMASK)) >> (k)) & 1u)
__global__ void __launch_bounds__(NT, 2) hymba_fwd(Args KA) {
    extern __shared__ __attribute__((aligned(16))) unsigned char lds_raw[];
    LAS unsigned char* lds = (LAS unsigned char*)lds_raw;
    const int G = gridDim.x, bid = blockIdx.x, NGW = G * NWAVES;
#define IDS() int tid_ = threadIdx.x; asm volatile("" : "+v"(tid_)); const int tid = tid_, lane = tid & 63, wave = __builtin_amdgcn_readfirstlane(tid >> 6), gw = bid * NWAVES + wave; (void)lane; (void)gw
    volatile LAS unsigned* MISC = (volatile LAS unsigned*)(lds + MISC_OFF);
    for (int u = threadIdx.x; u < (LDS_BYTES - LDSCTL_OFF) / 4; u += NT) ((LAS unsigned*)(lds + LDSCTL_OFF))[u] = 0u;
    __syncthreads();
    if (threadIdx.x < 32) { const int i = threadIdx.x; const unsigned long long v = i < 30 ? (unsigned long long)KA.in[i] : (i == 30 ? (unsigned long long)KA.out : (unsigned long long)KA.ws);
        *(LAS unsigned long long*)(lds + LARGS_OFF + 8 * i) = v; }
    __syncthreads();
    const LA A{};
    (void)xcd_barrier_post((unsigned*)(KA.ws + WS_CTL) + CW_BAR, MISC + 8);
#define GRID_BAR() do { XcdBarrier b_; b_.bar = (unsigned*)(A.W() + WS_CTL) + CW_BAR; b_.x = xb_xcc_id(); b_.st = MISC + 8; xcd_barrier(b_); } while (0)

    if (EN(0)) { IDS(); p0_rope(A, bid * NT + tid, G * NT); }
    if (EN(1)) { IDS(); p0_mod(A, lds, bid, G, tid, wave, lane); }
    if (EN(2)) { IDS(); p0_weights(A, lds, gw, NGW, wave, lane); }
    GRID_BAR();

#pragma unroll 1
    for (int l = 0; l < DEPTH; ++l) {
        const float* modl = (const float*)(A.W() + WS_MOD) + (size_t)l * NMR * NMOD;
        const float* xin_p = l == 0 ? A.I(0) : A.O() + O_YP;
        const float* xin_s = l == 0 ? A.I(1) : A.O() + O_YS;
        if (EN(3)) { IDS(); phase_norm(A, l, 0, gw, NGW, lane); }
        GRID_BAR();
        if (EN(4)) {   pg8::Gemm g{(const bf16*)(A.W() + WS_HA), (const bf16*)(A.W() + WS_WIN) + (size_t)l * NPROJ * DM, MP, NPROJ, DM}; pg8::StaticOrder S; S.init(MP, NPROJ, G, bid);
            pg8::EpiProj E{(bf16*)(A.W() + WS_PROJ), (float*)(A.W() + WS_DT)};
            pg8::gemm_phase<pg8::EpiProj, pg8::StaticOrder, PG8_ALIGN, PG8_SP2>(lds + RING_OFF, g, S, E);
            float* ps = (float*)(A.W() + WS_PROJS); IDS();
            skinny_gemm(lds, (const bf16*)(A.W() + WS_HA) + (size_t)MP * DM, g.Bt, NPROJ, DM, bid, G, tid, wave, lane, [=](int row, int col, float v) { if (col < PSP) ps[(size_t)row * PSP + col] = v; });
        }
        GRID_BAR();
        if (EN(6)) { IDS(); for (int u = bid; u < NBP * NCH * 2; u += G) ssd_chunk_state(A, lds, l, u, tid, wave, lane); }
        GRID_BAR();
        if (EN(7)) { IDS(); ssd_scan(A, l, bid, G, tid); }
        for (int u = bid; u < 128 + 128 + 64 + 64 + 8; u += G) { IDS();
            if (u < 128) { if (EN(8)) attn_unit(A, lds, l, u, tid, wave, lane); }
            else if (u < 256) { if (EN(9)) sconv_unit(A, l, u - 128, tid); }
            else if (u < 320) { if (EN(10)) samp_ssd_unit(A, lds, l, u - 256, tid, wave, lane); }
            else if (u < 384) { if (EN(11)) samp_attn_unit(A, lds, l, u - 320, tid, wave, lane); }
            else { if (EN(12)) samp_sconv_unit(A, l, u - 384, tid); }
        }
        GRID_BAR();
        if (EN(13)) { IDS(); for (int u = bid; u < NBP * NCH * 2; u += G) ssd_chunk_out(A, lds, l, u, tid, wave, lane); }
        GRID_BAR();
        if (EN(14)) {   pg8::Gemm g{(const bf16*)(A.W() + WS_MIX), (const bf16*)(A.W() + WS_WOUT) + (size_t)l * DM * DM, MP, DM, DM}; pg8::StaticOrder S; S.init(MP, DM, G, bid);
            pg8::EpiResid E{xin_p, A.O() + O_YP, modl + 2 * DM};
            pg8::gemm_phase<pg8::EpiResid, pg8::StaticOrder, PG8_ALIGN, PG8_SP2>(lds + RING_OFF, g, S, E);
            float* xo = A.O() + O_YS; const float* gate = modl + 2 * NMOD + 2 * DM; IDS();
            skinny_gemm(lds, (const bf16*)(A.W() + WS_MIX) + (size_t)MP * DM, g.Bt, DM, DM, bid, G, tid, wave, lane, [=](int row, int col, float v) { xo[(size_t)row * DM + col] = xin_s[(size_t)row * DM + col] + gate[(size_t)row * NMOD + col] * v; });
        }
        GRID_BAR();
        if (EN(15)) { IDS(); phase_norm(A, l, 1, gw, NGW, lane); }
        GRID_BAR();
        if (EN(16)) {   pg8::Gemm g{(const bf16*)(A.W() + WS_HA), (const bf16*)(A.W() + WS_WUP) + (size_t)l * 2 * DFF * DM, MP, 2 * DFF, DM}; pg8::StaticOrder S; S.init(MP, 2 * DFF, G, bid);
            pg8::EpiPlain E{(bf16*)(A.W() + WS_GU), 2 * DFF};
            pg8::gemm_phase<pg8::EpiPlain, pg8::StaticOrder, PG8_ALIGN, PG8_SP2>(lds + RING_OFF, g, S, E);
            float* gs = (float*)(A.W() + WS_GUS); IDS();
            skinny_gemm(lds, (const bf16*)(A.W() + WS_HA) + (size_t)MP * DM, g.Bt, 2 * DFF, DM, bid, G, tid, wave, lane, [=](int row, int col, float v) { gs[(size_t)row * (2 * DFF) + col] = v; });
        }
        GRID_BAR();
        if (EN(17)) for (int u = bid; u < NBP * 64 * 11 + MS; u += G) { IDS(); if (u < NBP * 64 * 11) act_unit(A, l, u, tid); else samp_act_unit(A, l, u - NBP * 64 * 11, tid); }
        GRID_BAR();
        if (EN(18)) {   pg8::Gemm g{(const bf16*)(A.W() + WS_ACT), (const bf16*)(A.W() + WS_WDN) + (size_t)l * DM * DFF, MP, DM, DFF}; pg8::StaticOrder S; S.init(MP, DM, G, bid);
            pg8::EpiResid E{A.O() + O_YP, A.O() + O_YP, modl + 5 * DM};
            pg8::gemm_phase<pg8::EpiResid, pg8::StaticOrder, PG8_ALIGN, PG8_SP2>(lds + RING_OFF, g, S, E);
            float* xo = A.O() + O_YS; const float* gate = modl + 2 * NMOD + 5 * DM; IDS();
            if (EN(19)) skinny_gemm(lds, (const bf16*)(A.W() + WS_ACT) + (size_t)MP * DFF, g.Bt, DM, DFF, bid, G, tid, wave, lane, [=](int row, int col, float v) { xo[(size_t)row * DM + col] += gate[(size_t)row * NMOD + col] * v; });
        }
        if (l + 1 < DEPTH) GRID_BAR();
    }
}

extern "C" void kernel_launch(void* const* d_in, const int* in_sizes, int n_in, void* d_out, int out_size, void* d_ws, size_t ws_size, hipStream_t stream) {
    static int grid = 0;
    if (grid == 0) {
        if (n_in != 30 || (size_t)out_size != O_END || ws_size < WS_END) { fprintf(stderr, "kernel_launch: unexpected shapes (n_in %d, out %d, ws %zu)\n", n_in, out_size, ws_size); grid = -1; return; }
        int dev = 0, cus = 0, per_cu = 0;
        if (hipGetDevice(&dev) != hipSuccess || hipDeviceGetAttribute(&cus, hipDeviceAttributeMultiprocessorCount, dev) != hipSuccess) { grid = -1; return; }
        if (hipFuncSetAttribute((const void*)hymba_fwd, hipFuncAttributeMaxDynamicSharedMemorySize, LDS_BYTES) != hipSuccess) { fprintf(stderr, "kernel_launch: hipFuncSetAttribute failed\n"); grid = -1; return; }
        if (hipOccupancyMaxActiveBlocksPerMultiprocessor(&per_cu, (const void*)hymba_fwd, NT, LDS_BYTES) != hipSuccess || per_cu < 1) { fprintf(stderr, "kernel_launch: occupancy query says %d blocks per CU\n", per_cu); }
        (void)hipGetLastError();
        grid = cus;
    }
    if (grid < 0) return;
    if (hipMemsetAsync((char*)d_ws + WS_CTL, 0, CTL_ZERO_BYTES, stream) != hipSuccess) return;
    Args a{};
    for (int i = 0; i < 30; ++i) a.in[i] = (const float*)d_in[i];
    a.out = (float*)d_out; a.ws = (unsigned char*)d_ws;
    hipLaunchKernelGGL(hymba_fwd, dim3(grid), dim3(NT), LDS_BYTES, stream, a);
    const hipError_t le = hipPeekAtLastError();
    if (le != hipSuccess) fprintf(stderr, "kernel_launch: launch failed: %s\n", hipGetErrorName(le));
}
```

```cpp
#include <hip/hip_runtime.h>
#include <cstdio>
#include <cstdint>
namespace pg8 {
#define PG8_LAS __attribute__((address_space(3)))
typedef unsigned short bf16_t;
typedef short bf16x8 __attribute__((ext_vector_type(8)));
typedef float f32x4 __attribute__((ext_vector_type(4)));
typedef unsigned u32x4 __attribute__((ext_vector_type(4)));
constexpr int BM = 256, BK = 64, HALF = 128, HTB = HALF * BK * 2  , STAGE_BYTES = 8 * HTB, NXCD = 8, WGM = 8;

__host__ __device__ __forceinline__ int lds_byte(int r, int c) { const int st = (r >> 4) * 2 + (c >> 5), rr = r & 15, cc = c & 31, ob = rr * 64 + cc * 2; return st * 1024 + (ob ^ (((ob >> 9) & 1) << 5)); }
__host__ __device__ __forceinline__ void stage_rc(int b, int& R, int& C) { const int st = b / 1024, sb = b % 1024, swz = sb ^ (((sb >> 9) & 1) << 5); R = (st >> 1) * 16 + swz / 64; C = (st & 1) * 32 + (swz % 64) / 2; }
__host__ __device__ __forceinline__ int perm32(int rho) { const int n = rho >> 4, i = rho & 15; return 8 * (i >> 2) + 4 * n + (i & 3); }

struct Unit { int pm, pn; };
struct Gemm { const bf16_t* A; const bf16_t* Bt; int M, N, K; };

struct StaticOrder {
    int nM, nN, nwg, G, c;
    __host__ __device__ void init(int M, int N, int G_, int c_) { nM = M / BM; nN = N / BM; nwg = nM * nN; G = G_; c = c_; }
    __host__ __device__ bool next(int i, Unit& u) const {
        const long L = (long)i * G + c; if (L >= nwg) return false;
        int wgid = (int)L; { const int q = nwg / NXCD, r = nwg % NXCD, xcd = wgid % NXCD, off = wgid / NXCD; wgid = (xcd < r ? xcd * (q + 1) : r * (q + 1) + (xcd - r) * q) + off; }
        const int nig = WGM * nN, gid = wgid / nig, fm = gid * WGM, gsz = (nM - fm) < WGM ? (nM - fm) : WGM;
        u.pm = fm + ((wgid % nig) % gsz); u.pn = (wgid % nig) / gsz; return true;
    }
    __device__ __forceinline__ void a_ready(const Unit&) const {}
    __device__ __forceinline__ void done(const Unit&) const {}
};

__device__ __forceinline__ unsigned cvt_pk_bf16(float lo, float hi) { unsigned r; asm volatile("v_cvt_pk_bf16_f32 %0, %1, %2" : "=v"(r) : "v"(lo), "v"(hi)); return r; }
typedef float f32x2 __attribute__((ext_vector_type(2)));
template <class Epi, class Sched, bool ALIGN_EPI = false, bool SP2 = false>
__device__ __forceinline__ void gemm_phase(PG8_LAS unsigned char* lds, const Gemm g, const Sched& S, const Epi& E) {
    int tid_ = threadIdx.x; asm volatile("" : "+v"(tid_));
    const int tid = tid_, wid = __builtin_amdgcn_readfirstlane(tid >> 6), lane = tid & 63, wr = wid >> 2, wc = wid & 3, fr = lane & 15, fq = lane >> 4;
    const int K = g.K, nt = K / BK;
    unsigned voffA[2], voffB[2];
#pragma unroll
    for (int i = 0; i < 2; ++i) { int R, C; stage_rc(tid * 16 + i * 8192, R, C); const int Rb = Epi::PERM ? ((R & ~31) + perm32(R & 31)) : R;
        voffA[i] = (unsigned)(R * K + C) * 2u; voffB[i] = (unsigned)(Rb * K + C) * 2u; }
    const size_t kstep = (size_t)(BK * 2);
    const size_t hstep = (size_t)HALF * K * 2;
    const size_t tstep = 2 * hstep;
    const unsigned ldsw = (unsigned)wid * 1024u;
    const int aoff = lds_byte(wr * 64 + fr, fq * 8), boff = lds_byte(wc * 32 + fr, fq * 8);
#define PG8_SA(b, h) (((b) * 2 + (h)) * HTB)
#define PG8_SB(b, h) ((4 + (b) * 2 + (h)) * HTB)
#define PG8_STAGE(bufoff, gbase, voff) do { _Pragma("unroll") for (int _i = 0; _i < 2; ++_i) \
        __builtin_amdgcn_global_load_lds((const unsigned*)((const char*)(gbase) + (voff)[_i]), (PG8_LAS unsigned*)(lds + (bufoff) + ldsw + _i * 8192), 16, 0, 0); } while (0)
#define PG8_LDA(dst, b, h) do { _Pragma("unroll") for (int m = 0; m < 4; ++m) _Pragma("unroll") for (int k = 0; k < 2; ++k) dst[m][k] = *(const PG8_LAS bf16x8*)(lds + PG8_SA(b, h) + aoff + m * 2048 + k * 1024); } while (0)
#define PG8_LDB(dst, b, h) do { _Pragma("unroll") for (int n = 0; n < 2; ++n) _Pragma("unroll") for (int k = 0; k < 2; ++k) dst[n][k] = *(const PG8_LAS bf16x8*)(lds + PG8_SB(b, h) + boff + n * 2048 + k * 1024); } while (0)
#define PG8_MMA(ai, bj, At, Bt) do { __builtin_amdgcn_s_setprio(1); _Pragma("unroll") for (int m = 0; m < 4; ++m) _Pragma("unroll") for (int n = 0; n < 2; ++n) _Pragma("unroll") for (int k = 0; k < 2; ++k) \
        acc[ai][bj][m][n] = __builtin_amdgcn_mfma_f32_16x16x32_bf16(Bt[n][k], At[m][k], acc[ai][bj][m][n], 0, 0, 0); __builtin_amdgcn_s_setprio(0); } while (0)
#define PG8_WAIT_V(n) asm volatile("s_waitcnt vmcnt(" #n ")" ::: "memory")
#define PG8_WAIT_L(n) asm volatile("s_waitcnt lgkmcnt(" #n ")" ::: "memory")
#define PG8_BAR __builtin_amdgcn_s_barrier()
#define PG8_SCHED __builtin_amdgcn_sched_barrier(0)
    Unit cur, nxt; int ui = 0;
    if (!S.next(0, cur)) return;
    f32x4 acc[2][2][4][2];
#pragma unroll
    for (int a = 0; a < 2; ++a)
#pragma unroll
        for (int b = 0; b < 2; ++b)
#pragma unroll
            for (int m = 0; m < 4; ++m)
#pragma unroll
                for (int n = 0; n < 2; ++n) acc[a][b][m][n] = (f32x4){0.f, 0.f, 0.f, 0.f};
    bf16x8 At[4][2], B0[2][2], B1[2][2];
    const char* cA = (const char*)g.A + (size_t)cur.pm * tstep; const char* cB = (const char*)g.Bt + (size_t)cur.pn * tstep;
    S.a_ready(cur);
    if constexpr (SP2) {
        PG8_STAGE(PG8_SB(0, 0), cB, voffB); PG8_STAGE(PG8_SB(0, 1), cB + hstep, voffB); PG8_STAGE(PG8_SA(0, 0), cA, voffA); PG8_STAGE(PG8_SA(0, 1), cA + hstep, voffA);
        if (wr == 1) PG8_BAR;
        PG8_WAIT_V(2); PG8_BAR;
        PG8_STAGE(PG8_SB(1, 0), cB + kstep, voffB); PG8_STAGE(PG8_SA(1, 0), cA + kstep, voffA); PG8_STAGE(PG8_SB(1, 1), cB + hstep + kstep, voffB);
        PG8_WAIT_V(6); PG8_BAR;
    } else {
        PG8_STAGE(PG8_SB(0, 0), cB, voffB); PG8_STAGE(PG8_SA(0, 0), cA, voffA); PG8_STAGE(PG8_SB(0, 1), cB + hstep, voffB); PG8_STAGE(PG8_SA(0, 1), cA + hstep, voffA);
        if (wr == 1) PG8_BAR;
        PG8_WAIT_V(4); PG8_BAR;
        PG8_STAGE(PG8_SB(1, 0), cB + kstep, voffB); PG8_STAGE(PG8_SA(1, 0), cA + kstep, voffA); PG8_STAGE(PG8_SB(1, 1), cB + hstep + kstep, voffB);
        PG8_WAIT_V(6); PG8_BAR;
    }
    for (;;) {
        const bool has_next = S.next(ui + 1, nxt);
        const char* nA = has_next ? (const char*)g.A + (size_t)nxt.pm * tstep : cA; const char* nB = has_next ? (const char*)g.Bt + (size_t)nxt.pn * tstep : cB;
        for (int t = 0; t < nt; t += 2) {
            const bool last = (t == nt - 2);
            const char* a1 = cA + (size_t)(t + 1) * kstep;
            const char* a2 = last ? nA : cA + (size_t)(t + 2) * kstep; const char* b2 = last ? nB : cB + (size_t)(t + 2) * kstep;
            const char* a3 = a2 + kstep; const char* b3 = b2 + kstep;
            if (last && has_next) S.a_ready(nxt);
            if constexpr (SP2) {
            PG8_LDB(B0, 0, 0); PG8_LDB(B1, 0, 1); PG8_SCHED; PG8_LDA(At, 0, 0); PG8_STAGE(PG8_SA(1, 1), a1 + hstep, voffA);
            PG8_WAIT_V(8); PG8_WAIT_L(0); PG8_BAR; PG8_MMA(0, 0, At, B0); PG8_MMA(0, 1, At, B1); PG8_BAR; PG8_SCHED;
            PG8_LDA(At, 0, 1); PG8_STAGE(PG8_SB(0, 0), b2, voffB); PG8_STAGE(PG8_SB(0, 1), b2 + hstep, voffB); PG8_STAGE(PG8_SA(0, 0), a2, voffA);
            PG8_WAIT_V(8); PG8_WAIT_L(0); PG8_BAR; PG8_MMA(1, 0, At, B0); PG8_MMA(1, 1, At, B1); PG8_BAR; PG8_SCHED;
            PG8_LDB(B0, 1, 0); PG8_LDB(B1, 1, 1); PG8_SCHED; PG8_LDA(At, 1, 0); PG8_STAGE(PG8_SA(0, 1), a2 + hstep, voffA);
            PG8_WAIT_V(8); PG8_WAIT_L(0); PG8_BAR; PG8_MMA(0, 0, At, B0); PG8_MMA(0, 1, At, B1); PG8_BAR; PG8_SCHED;
            PG8_LDA(At, 1, 1); PG8_STAGE(PG8_SB(1, 0), b3, voffB); PG8_STAGE(PG8_SB(1, 1), b3 + hstep, voffB); PG8_STAGE(PG8_SA(1, 0), a3, voffA);
            PG8_WAIT_V(8); PG8_WAIT_L(0); PG8_BAR; PG8_MMA(1, 0, At, B0); PG8_MMA(1, 1, At, B1); PG8_BAR; PG8_SCHED;
            } else {
            PG8_LDB(B0, 0, 0); PG8_SCHED; PG8_LDA(At, 0, 0); PG8_STAGE(PG8_SA(1, 1), a1 + hstep, voffA);
            PG8_WAIT_L(8); PG8_BAR; PG8_WAIT_L(0); PG8_MMA(0, 0, At, B0); PG8_BAR; PG8_SCHED;
            PG8_LDB(B1, 0, 1); PG8_STAGE(PG8_SB(0, 0), b2, voffB);
            PG8_BAR; PG8_WAIT_L(0); PG8_MMA(0, 1, At, B1); PG8_BAR;
            PG8_LDA(At, 0, 1); PG8_STAGE(PG8_SA(0, 0), a2, voffA);
            PG8_BAR; PG8_WAIT_L(0); PG8_MMA(1, 0, At, B0); PG8_BAR; PG8_SCHED;
            PG8_STAGE(PG8_SB(0, 1), b2 + hstep, voffB);
            PG8_WAIT_V(6); PG8_BAR; PG8_MMA(1, 1, At, B1); PG8_BAR;
            PG8_LDB(B0, 1, 0); PG8_SCHED; PG8_LDA(At, 1, 0); PG8_STAGE(PG8_SA(0, 1), a2 + hstep, voffA);
            PG8_WAIT_L(8); PG8_BAR; PG8_WAIT_L(0); PG8_MMA(0, 0, At, B0); PG8_BAR; PG8_SCHED;
            PG8_LDB(B1, 1, 1); PG8_STAGE(PG8_SB(1, 0), b3, voffB);
            PG8_BAR; PG8_WAIT_L(0); PG8_MMA(0, 1, At, B1); PG8_BAR;
            PG8_LDA(At, 1, 1); PG8_STAGE(PG8_SA(1, 0), a3, voffA);
            PG8_BAR; PG8_WAIT_L(0); PG8_MMA(1, 0, At, B0); PG8_BAR; PG8_SCHED;
            PG8_STAGE(PG8_SB(1, 1), b3 + hstep, voffB);
            PG8_WAIT_V(6); PG8_BAR; PG8_MMA(1, 1, At, B1); PG8_BAR;
            }
        }
        if constexpr (ALIGN_EPI) { if (wr == 0) PG8_BAR; }
        if constexpr (!Epi::AFTER_DRAIN) { E(acc, cur, wr, wc, fr, fq); S.done(cur); }
        if (!has_next) break;
#pragma unroll
        for (int a = 0; a < 2; ++a)
#pragma unroll
            for (int b = 0; b < 2; ++b)
#pragma unroll
                for (int m = 0; m < 4; ++m)
#pragma unroll
                    for (int n = 0; n < 2; ++n) acc[a][b][m][n] = (f32x4){0.f, 0.f, 0.f, 0.f};
        cur = nxt; cA = nA; cB = nB; ++ui;
        if constexpr (ALIGN_EPI) { if (wr == 1) PG8_BAR; }
    }
    PG8_WAIT_V(0);
    if constexpr (!ALIGN_EPI) { if (wr == 0) PG8_BAR; }
    PG8_BAR;
    if constexpr (Epi::AFTER_DRAIN) { E.fused(acc, cur, wr, wc, fr, fq, lds, wid, lane); S.done(cur); }
#undef PG8_SA
#undef PG8_SB
#undef PG8_STAGE
#undef PG8_LDA
#undef PG8_LDB
#undef PG8_MMA
#undef PG8_WAIT_V
#undef PG8_WAIT_L
#undef PG8_BAR
#undef PG8_SCHED
}
}

#ifndef PG8_SP2
#define PG8_SP2 true
#endif
#ifndef PG8_ALIGN
#define PG8_ALIGN true
#endif
#define GAS __attribute__((address_space(1)))
#define LAS __attribute__((address_space(3)))
typedef unsigned short bf16;
typedef unsigned v4u __attribute__((ext_vector_type(4)));
typedef float f32x4 __attribute__((ext_vector_type(4)));
typedef short bf16x8 __attribute__((ext_vector_type(8)));
typedef GAS unsigned gu32;
typedef GAS unsigned long long gu64;
#define RLX_AGENT __ATOMIC_RELAXED, __HIP_MEMORY_SCOPE_AGENT
#define LDS_WAIT() asm volatile("s_waitcnt lgkmcnt(0)" ::: "memory")
#define VM_WAIT() asm volatile("s_waitcnt vmcnt(0)" ::: "memory")
__device__ __forceinline__ unsigned long long rt() { return __builtin_amdgcn_s_memrealtime(); }
__device__ __forceinline__ unsigned f2bf(float f) { unsigned u = __builtin_bit_cast(unsigned, f); return (u + 0x7fffu + ((u >> 16) & 1u)) >> 16; }
__device__ __forceinline__ unsigned pk2(float lo, float hi) { return f2bf(lo) | (f2bf(hi) << 16); }
#define XB_TMO      128
#define XB_XCNT(j)  (256  + 64 * (j))
#define XB_XSUB(j)  (1280 + 64 * (j))
#define XB_XGEN(j)  (2304 + 64 * (j))
#define XB_TOP      3328
#define XB_TOPGEN   3392
#define XCD_BAR_WORDS 3456
#define XB_SPIN_CAP (1u << 18)

__device__ __forceinline__ unsigned xb_ld(unsigned* p)              { return __hip_atomic_load(p, __ATOMIC_RELAXED, __HIP_MEMORY_SCOPE_AGENT); }
__device__ __forceinline__ unsigned xb_add(unsigned* p, unsigned v) { return __hip_atomic_fetch_add(p, v, __ATOMIC_RELAXED, __HIP_MEMORY_SCOPE_AGENT); }
__device__ __forceinline__ unsigned xb_xcc_id() { return (unsigned)__builtin_amdgcn_s_getreg((3 << 11) | 20) & 0xFu; }
#define XB_SPIN(cond, bar) do { unsigned _sp = 0; while (cond) { __builtin_amdgcn_s_sleep(1); \
    if ((++_sp & 255u) == 0u) { if (xb_ld(&(bar)[XB_TMO])) break; if (_sp > XB_SPIN_CAP) { atomicAdd(&(bar)[XB_TMO], 1u); break; } } } } while (0)

struct XcdBarrier {
    unsigned* bar; unsigned x;
    volatile LAS unsigned* st;
};

__device__ __forceinline__ XcdBarrier xcd_barrier_post(unsigned* bar, volatile LAS unsigned* st) {
    XcdBarrier b; b.bar = bar; b.x = xb_xcc_id(); b.st = st;
    if (threadIdx.x == 0) (void)xb_add(&bar[XB_XCNT(b.x)], 1u);
    return b;
}
__device__ __forceinline__ void xcd_barrier_complete(unsigned* bar, unsigned x, unsigned& nloc, unsigned& nx) {
    const unsigned G = gridDim.x * gridDim.y * gridDim.z;
    unsigned sum, cnt, mine, sp = 0u;
    for (;;) {
        sum = 0u; cnt = 0u; mine = 0u;
#pragma unroll
        for (unsigned j = 0; j < 16; ++j) { const unsigned c = xb_ld(&bar[XB_XCNT(j)]); sum += c; cnt += (c > 0u) ? 1u : 0u; mine = (j == x) ? c : mine; }
        if (sum == G) break;
        __builtin_amdgcn_s_sleep(1);
        if ((++sp & 255u) == 0u) { if (xb_ld(&bar[XB_TMO])) break; if (sp > XB_SPIN_CAP) { atomicAdd(&bar[XB_TMO], 1u); break; } }
    }
    nloc = mine > 0u ? mine : 1u; nx = cnt > 0u ? cnt : 1u;
}

__device__ __forceinline__ void xcd_barrier(const XcdBarrier& b) {
    asm volatile("s_waitcnt vmcnt(0)" ::: "memory");
    __syncthreads();
    if (threadIdx.x == 0) {
        unsigned* bar = b.bar;
        __builtin_amdgcn_s_waitcnt(0);
        unsigned nloc = b.st[0], nx = b.st[1];
        if (nloc == 0u) { xcd_barrier_complete(bar, b.x, nloc, nx); b.st[0] = nloc; b.st[1] = nx; }
        const unsigned old = xb_add(&bar[XB_XSUB(b.x)], 1u);
        const unsigned gen = old / nloc;
        if (old + 1u == (gen + 1u) * nloc) {
            __builtin_amdgcn_fence(__ATOMIC_RELEASE, "agent");
            asm volatile("s_waitcnt vmcnt(0)" ::: "memory");
            const unsigned og = xb_add(&bar[XB_TOP], 1u);
            const unsigned tg = og / nx;
            if (og + 1u == (tg + 1u) * nx) xb_add(&bar[XB_TOPGEN], 1u);
            else XB_SPIN(xb_ld(&bar[XB_TOPGEN]) == tg, bar);
            __builtin_amdgcn_fence(__ATOMIC_ACQUIRE, "agent");
            xb_add(&bar[XB_XGEN(b.x)], 1u);
            asm volatile("s_waitcnt vmcnt(0)" ::: "memory");
        } else {
            XB_SPIN(xb_ld(&bar[XB_XGEN(b.x)]) == gen, bar);
            __builtin_amdgcn_fence(__ATOMIC_ACQUIRE, "agent");
            asm volatile("s_waitcnt vmcnt(0)" ::: "memory");
        }
    }
    __syncthreads();
}

constexpr int NWAVES = 8, NT = 512;
constexpr int DM = 2048, SEQ = 4096, NBP = 2, MP = NBP * SEQ, MS = 32, MT = MP + MS, MPAD = MP + 256, DEPTH = 4;
constexpr int DSSD = 1024, DXBC = 1536, NH = 16, HP = 64, DST = 128;
constexpr int NQH = 8, NKV = 2, HD = 64, WIN = 128;
constexpr int DCONV = 512, DFF = 5632;
constexpr int NPROJ = 5120, PP = 4864, PSP = 4880;
constexpr int C_Z = 0, C_X = 1024, C_B = 2048, C_C = 2304, C_Q = 2560, C_K = 3072, C_V = 3200, C_GB = 3328, C_GC = 3840, C_HC = 4352, C_DT = 4864;
constexpr int NMOD = 12288, NMR = 34;
constexpr float EPS = 1e-6f;
constexpr int NCH = 64, CL = 64;

constexpr size_t O_YP = 0;
constexpr size_t O_YS = O_YP + (size_t)MP * DM;
constexpr size_t O_PSSM = O_YS + (size_t)MS * DM;
constexpr size_t O_PSSMCONV = O_PSSM + (size_t)DEPTH * NBP * NH * HP * DST;
constexpr size_t O_PWK = O_PSSMCONV + (size_t)DEPTH * NBP * 3 * DXBC;
constexpr size_t O_PWV = O_PWK + (size_t)DEPTH * NBP * WIN * NKV * HD;
constexpr size_t O_PSC = O_PWV + (size_t)DEPTH * NBP * WIN * NKV * HD;
constexpr size_t O_PFC = O_PSC + (size_t)DEPTH * NBP * 2 * DCONV;
constexpr size_t O_SSSM = O_PFC + (size_t)DEPTH * NBP * 2 * DFF;
constexpr size_t O_SSSMCONV = O_SSSM + (size_t)DEPTH * MS * NH * HP * DST;
constexpr size_t O_SWK = O_SSSMCONV + (size_t)DEPTH * MS * 3 * DXBC;
constexpr size_t O_SWV = O_SWK + (size_t)DEPTH * MS * WIN * NKV * HD;
constexpr size_t O_SSC = O_SWV + (size_t)DEPTH * MS * WIN * NKV * HD;
constexpr size_t O_SFC = O_SSC + (size_t)DEPTH * MS * 2 * DCONV;
constexpr size_t O_END = O_SFC + (size_t)DEPTH * MS * 2 * DFF;
static_assert(O_END == 41422848, "output size");

constexpr size_t MiB = 1u << 20;
constexpr size_t WS_CTL = 0, CTL_ZERO_BYTES = 1 * MiB;
constexpr size_t WS_WIN = 2 * MiB;
constexpr size_t WS_WOUT = 82 * MiB;
constexpr size_t WS_WUP = 114 * MiB;
constexpr size_t WS_WDN = 290 * MiB;
constexpr size_t WS_HA = 378 * MiB;
constexpr size_t WS_PROJ = 411 * MiB;
constexpr size_t WS_DT = 490 * MiB;
constexpr size_t WS_ST = 492 * MiB;
constexpr size_t WS_DECAY = 524 * MiB;
constexpr size_t WS_MIX = 525 * MiB;
constexpr size_t WS_GU = 558 * MiB;
constexpr size_t WS_ACT = 740 * MiB;
constexpr size_t WS_MOD = 829 * MiB;
constexpr size_t WS_ROPE = 836 * MiB;
constexpr size_t WS_END = 838 * MiB;
constexpr int CW_BAR = 4096;

constexpr int RING_OFF = 0, RING_BYTES = 131072;
constexpr int LDSCTL_OFF = RING_BYTES, MISC_OFF = LDSCTL_OFF + 320;
constexpr int LDS_BYTES = 147456;

typedef float f32x16 __attribute__((ext_vector_type(16)));
typedef float f32x2_t __attribute__((ext_vector_type(2)));
typedef __bf16 bf16x2_t __attribute__((ext_vector_type(2)));
typedef short s16x4 __attribute__((ext_vector_type(4)));
typedef short v4i16_t __attribute__((ext_vector_type(4)));
typedef unsigned v2u __attribute__((ext_vector_type(2)));

struct Args { const float* in[30]; float* out; unsigned char* ws; };
constexpr int LARGS_OFF = 131072 + 1024;
struct LA {
    __device__ __forceinline__ unsigned long long ld(int i) const { const unsigned long long v = *(const __attribute__((address_space(3))) unsigned long long*)(unsigned)(LARGS_OFF + 8 * i);
        const unsigned lo = __builtin_amdgcn_readfirstlane((unsigned)v), hi = __builtin_amdgcn_readfirstlane((unsigned)(v >> 32)); return ((unsigned long long)hi << 32) | lo; }
    __device__ __forceinline__ const float* I(int i) const { return (const float*)ld(i); }
    __device__ __forceinline__ float* O() const { return (float*)ld(30); }
    __device__ __forceinline__ unsigned char* W() const { return (unsigned char*)ld(31); }
};

#define DI __device__ __forceinline__
struct PSrow { const bf16* p; const float* d; DI float operator[](int col) const { return col >= C_DT ? d[col - C_DT] : __uint_as_float((unsigned)p[col] << 16); } };
struct GSrow { const bf16* p; DI float operator[](int col) const { return __uint_as_float((unsigned)p[col] << 16); } };
DI unsigned cvtpk(float lo, float hi) { f32x2_t v = {lo, hi}; bf16x2_t b = __builtin_convertvector(v, bf16x2_t); return __builtin_bit_cast(unsigned, b); }
DI float bflo(unsigned u) { return __uint_as_float(u << 16); }
DI float bfhi(unsigned u) { return __uint_as_float(u & 0xffff0000u); }
DI void unpack8(const v4u v, float* f) { f[0] = bflo(v.x); f[1] = bfhi(v.x); f[2] = bflo(v.y); f[3] = bfhi(v.y); f[4] = bflo(v.z); f[5] = bfhi(v.z); f[6] = bflo(v.w); f[7] = bfhi(v.w); }
DI void unpack4(const v2u v, float* f) { f[0] = bflo(v.x); f[1] = bfhi(v.x); f[2] = bflo(v.y); f[3] = bfhi(v.y); }
DI v4u pack8(const float* f) { v4u o; o.x = cvtpk(f[0], f[1]); o.y = cvtpk(f[2], f[3]); o.z = cvtpk(f[4], f[5]); o.w = cvtpk(f[6], f[7]); return o; }
DI float silu_f(float x) { return x / (1.f + __expf(-x)); }
DI float softplus_f(float x) { return x > 20.f ? x : log1pf(__expf(x)); }
DI float wave_sum(float v) {
#pragma unroll
    for (int o = 1; o < 64; o <<= 1) v += __shfl_xor(v, o);
    return v;
}
DI float wave_max(float v) {
#pragma unroll
    for (int o = 1; o < 64; o <<= 1) v = fmaxf(v, __shfl_xor(v, o));
    return v;
}
DI float wave_incl_scan(float v, int lane) {
#pragma unroll
    for (int o = 1; o < 64; o <<= 1) { const float t = __shfl_up(v, o); if (lane >= o) v += t; }
    return v;
}
DI int crow(int reg, int h) { return (reg & 3) + 8 * (reg >> 2) + 4 * h; }
DI s16x4 tr_rd(const LAS unsigned char* p) { return __builtin_bit_cast(s16x4, __builtin_amdgcn_ds_read_tr16_b64_v4i16((LAS v4i16_t*)p)); }
DI bf16x8 tr_pair(const LAS unsigned char* plo, const LAS unsigned char* phi) { const s16x4 lo = tr_rd(plo), hi = tr_rd(phi); return __builtin_shufflevector(lo, hi, 0, 1, 2, 3, 4, 5, 6, 7); }
#define MFMA32(a, b, c) __builtin_amdgcn_mfma_f32_32x32x16_bf16((a), (b), (c), 0, 0, 0)
#define MFMA16(a, b, c) __builtin_amdgcn_mfma_f32_16x16x32_bf16((a), (b), (c), 0, 0, 0)
DI bf16x8 pack_frag(const f32x16& x, int s) {
    v4u p; p.x = cvtpk(x[8 * s + 0], x[8 * s + 1]); p.y = cvtpk(x[8 * s + 2], x[8 * s + 3]); p.z = cvtpk(x[8 * s + 4], x[8 * s + 5]); p.w = cvtpk(x[8 * s + 6], x[8 * s + 7]);
    return __builtin_bit_cast(bf16x8, p);
}
DI f32x16 zero16() { f32x16 z; for (int i = 0; i < 16; ++i) z[i] = 0.f; return z; }

template <bool WINMAP>
DI void p0_transpose_item(const float* W, int K, int Nsrc, int Ndst, bf16* WT, LAS float* scr, int item, int lane) {
    const int nblk = Ndst / 32, kb = item / nblk, nb = item % nblk, k0 = 64 * kb, n0 = 32 * nb;
    int src = n0 + (lane & 31); bool ok = true;
    if (WINMAP) { const int n = src; if (n < 2560) src = n; else if (n < 4864) src = n + 16; else if (n < 4880) src = n - 4864 + 2560; else { ok = false; src = 0; } }
    float v[32];
#pragma unroll
    for (int i = 0; i < 32; ++i) { const int kk = 2 * i + (lane >> 5); v[i] = W[(size_t)(k0 + kk) * Nsrc + src]; }
#pragma unroll
    for (int i = 0; i < 32; ++i) { const int kk = 2 * i + (lane >> 5); scr[kk * 33 + (lane & 31)] = ok ? v[i] : 0.f; }
    LDS_WAIT(); asm volatile("" ::: "memory");
    const int c = lane & 7;
#pragma unroll
    for (int j = 0; j < 4; ++j) { const int n = (lane >> 3) + 8 * j; const LAS float* s = scr + (8 * c) * 33 + n;
        v4u o; o.x = cvtpk(s[0 * 33], s[1 * 33]); o.y = cvtpk(s[2 * 33], s[3 * 33]); o.z = cvtpk(s[4 * 33], s[5 * 33]); o.w = cvtpk(s[6 * 33], s[7 * 33]);
        *(GAS v4u*)(WT + (size_t)(n0 + n) * K + k0 + 8 * c) = o; }
    LDS_WAIT(); asm volatile("" ::: "memory");
}

DI void p0_weights(const LA& A, LAS unsigned char* lds, int gw, int NGW, int wave, int lane) {
    LAS float* scr = (LAS float*)(lds + wave * 16384);
    constexpr int I_IN = (DM / 64) * (NPROJ / 32), I_OUT = (DM / 64) * (DM / 32), I_UP = (DM / 64) * (2 * DFF / 32), I_DN = (DFF / 64) * (DM / 32);
    constexpr int I_L = I_IN + I_OUT + I_UP + I_DN;
    for (int it = gw; it < DEPTH * I_L; it += NGW) {
        const int l = it / I_L; int r = it % I_L;
        if (r < I_IN) { p0_transpose_item<true>(A.I(14) + (size_t)l * DM * PSP, DM, PSP, NPROJ, (bf16*)(A.W() + WS_WIN) + (size_t)l * NPROJ * DM, scr, r, lane); continue; } r -= I_IN;
        if (r < I_OUT) { p0_transpose_item<false>(A.I(25) + (size_t)l * DM * DM, DM, DM, DM, (bf16*)(A.W() + WS_WOUT) + (size_t)l * DM * DM, scr, r, lane); continue; } r -= I_OUT;
        if (r < I_UP) { p0_transpose_item<false>(A.I(26) + (size_t)l * DM * 2 * DFF, DM, 2 * DFF, 2 * DFF, (bf16*)(A.W() + WS_WUP) + (size_t)l * 2 * DFF * DM, scr, r, lane); continue; } r -= I_UP;
        p0_transpose_item<false>(A.I(29) + (size_t)l * DFF * DM, DFF, DM, DM, (bf16*)(A.W() + WS_WDN) + (size_t)l * DM * DFF, scr, r, lane);
    }
}

DI void p0_mod(const LA& A, LAS unsigned char* lds, int bid, int G, int tid, int wave, int lane) {
    LAS float* sl = (LAS float*)lds;
    const float* cp = A.I(8); const float* csm = A.I(9);
    float* mod = (float*)(A.W() + WS_MOD);
    for (int u = bid; u < DEPTH * (NMOD / 64); u += G) {
        const int l = u / (NMOD / 64), nb = u % (NMOD / 64);
        const float* W = A.I(12) + (size_t)l * DM * NMOD + nb * 64 + lane;
        float acc[NMR];
#pragma unroll
        for (int r = 0; r < NMR; ++r) acc[r] = 0.f;
        for (int ch = 0; ch < 4; ++ch) {
            __syncthreads();
            for (int i = tid; i < 8 * NMR * 64; i += NT) { const int q = i / (NMR * 64), r = (i / 64) % NMR, kk = i & 63; const int k = q * 256 + ch * 64 + kk;
                const float c = r < 2 ? cp[r * DM + k] : csm[(r - 2) * DM + k]; sl[i] = silu_f(c); }
            __syncthreads();
            const float* Wk = W + (size_t)(wave * 256 + ch * 64) * NMOD;
            const LAS float* sw = sl + wave * NMR * 64;
#pragma unroll 2
            for (int k4 = 0; k4 < 16; ++k4) {
                const float w0 = Wk[(size_t)(4 * k4 + 0) * NMOD], w1 = Wk[(size_t)(4 * k4 + 1) * NMOD], w2 = Wk[(size_t)(4 * k4 + 2) * NMOD], w3 = Wk[(size_t)(4 * k4 + 3) * NMOD];
#pragma unroll
                for (int r = 0; r < NMR; ++r) { const f32x4 s = *(const LAS f32x4*)(sw + r * 64 + 4 * k4); acc[r] += s.x * w0 + s.y * w1 + s.z * w2 + s.w * w3; }
            }
        }
        __syncthreads();
#pragma unroll
        for (int r = 0; r < NMR; ++r) sl[(wave * NMR + r) * 64 + lane] = acc[r];
        __syncthreads();
        for (int i = tid; i < NMR * 64; i += NT) { const int r = i >> 6, n = i & 63; float s = A.I(13)[(size_t)l * NMOD + nb * 64 + n];
#pragma unroll
            for (int w = 0; w < 8; ++w) s += sl[(w * NMR + r) * 64 + n];
            mod[((size_t)l * NMR + r) * NMOD + nb * 64 + n] = s; }
    }
    __syncthreads();
}

DI void p0_rope(const LA& A, int gt, int NGT) {
    float* tab = (float*)(A.W() + WS_ROPE);
    for (int i = gt; i < 4097 * 32; i += NGT) { const int pi = i >> 5, j = i & 31; const float pos = pi < 4096 ? (float)pi : 16384.f;
        const float inv = powf(10000.f, -(float)j / 32.f); const float ang = pos * inv; float s, c; sincosf(ang, &s, &c); tab[2 * i] = c; tab[2 * i + 1] = s; }
}

DI void phase_norm(const LA& A, int l, int which, int gw, int NGW, int lane) {
    const bool first = (l == 0 && which == 0);
    const float* xp = first ? A.I(0) : A.O() + O_YP;
    const float* xs = first ? A.I(1) : A.O() + O_YS;
    const float* nw = A.I(which ? 11 : 10) + (size_t)l * DM;
    const float* mod = (const float*)(A.W() + WS_MOD) + (size_t)l * NMR * NMOD + (which ? 3 : 0) * DM;
    bf16* hA = (bf16*)(A.W() + WS_HA);
    for (int row = gw; row < MT; row += NGW) {
        const float* xr = row < MP ? xp + (size_t)row * DM : xs + (size_t)(row - MP) * DM;
        const int b = row < MP ? row / SEQ : 2 + row - MP;
        const float* sh = mod + (size_t)b * NMOD; const float* sc = sh + DM;
        f32x4 v[8]; float ss = 0.f;
#pragma unroll
        for (int j = 0; j < 8; ++j) { v[j] = ((const GAS f32x4*)xr)[lane + 64 * j]; ss += (v[j].x * v[j].x + v[j].y * v[j].y) + (v[j].z * v[j].z + v[j].w * v[j].w); }
        const float rstd = 1.f / sqrtf(wave_sum(ss) * (1.f / DM) + EPS);
#pragma unroll
        for (int j = 0; j < 8; ++j) { const f32x4 w = ((const GAS f32x4*)nw)[lane + 64 * j], s = ((const GAS f32x4*)sc)[lane + 64 * j], t = ((const GAS f32x4*)sh)[lane + 64 * j];
            const f32x4 o = v[j] * rstd * w * (1.f + s) + t; v2u pk; pk.x = cvtpk(o.x, o.y); pk.y = cvtpk(o.z, o.w);
            *(GAS v2u*)(hA + (size_t)row * DM + 4 * (lane + 64 * j)) = pk; }
    }
}

namespace pg8 {
struct EpiProj {
    static constexpr bool PERM = true, AFTER_DRAIN = false;
    bf16_t* O; float* DT;
    __device__ __forceinline__ void operator()(const f32x4 (&acc)[2][2][4][2], const Unit& u, int wr, int wc, int fr, int fq) const {
        const int row0 = u.pm * BM + wr * 64 + fr;
        if (u.pn < 19) {
            const int col0 = u.pn * BM + wc * 32 + 8 * fq;
#pragma unroll
            for (int ai = 0; ai < 2; ++ai)
#pragma unroll
                for (int m = 0; m < 4; ++m) { bf16_t* rowp = O + (size_t)(row0 + ai * HALF + m * 16) * PP + col0;
#pragma unroll
                    for (int bj = 0; bj < 2; ++bj) { const f32x4 v0 = acc[ai][bj][m][0], v1 = acc[ai][bj][m][1];
                        u32x4 w; w.x = cvtpk(v0[0], v0[1]); w.y = cvtpk(v0[2], v0[3]); w.z = cvtpk(v1[0], v1[1]); w.w = cvtpk(v1[2], v1[3]);
                        *(u32x4*)(rowp + bj * HALF) = w; } }
        } else if (wc == 0 && fq < 2) {
#pragma unroll
            for (int ai = 0; ai < 2; ++ai)
#pragma unroll
                for (int m = 0; m < 4; ++m) { float* dp = DT + (size_t)(row0 + ai * HALF + m * 16) * 16 + 8 * fq;
                    *(f32x4*)dp = acc[ai][0][m][0]; *(f32x4*)(dp + 4) = acc[ai][0][m][1]; }
        }
    }
};
struct EpiResid {
    static constexpr bool PERM = false, AFTER_DRAIN = false;
    const float* xin; float* xout; const float* gate;
    __device__ __forceinline__ void operator()(const f32x4 (&acc)[2][2][4][2], const Unit& u, int wr, int wc, int fr, int fq) const {
        const int row0 = u.pm * BM + wr * 64 + fr, col0 = u.pn * BM + wc * 32 + 4 * fq;
        const float* gp = gate + (size_t)(u.pm / 16) * NMOD + col0;
        f32x4 gv[2][2];
#pragma unroll
        for (int bj = 0; bj < 2; ++bj)
#pragma unroll
            for (int n = 0; n < 2; ++n) gv[bj][n] = *(const f32x4*)(gp + bj * HALF + n * 16);
#pragma unroll
        for (int ai = 0; ai < 2; ++ai)
#pragma unroll
            for (int m = 0; m < 4; ++m) { const size_t off = (size_t)(row0 + ai * HALF + m * 16) * DM + col0;
#pragma unroll
                for (int bj = 0; bj < 2; ++bj)
#pragma unroll
                    for (int n = 0; n < 2; ++n) { const f32x4 xv = *(const f32x4*)(xin + off + bj * HALF + n * 16); *(f32x4*)(xout + off + bj * HALF + n * 16) = xv + gv[bj][n] * acc[ai][bj][m][n]; }
                asm volatile("" ::: "memory"); }
    }
};
struct EpiPlain {
    static constexpr bool PERM = true, AFTER_DRAIN = false;
    bf16_t* O; int ldc;
    __device__ __forceinline__ void operator()(const f32x4 (&acc)[2][2][4][2], const Unit& u, int wr, int wc, int fr, int fq) const {
        const int row0 = u.pm * BM + wr * 64 + fr, col0 = u.pn * BM + wc * 32 + 8 * fq;
#pragma unroll
        for (int ai = 0; ai < 2; ++ai)
#pragma unroll
            for (int m = 0; m < 4; ++m) { bf16_t* rowp = O + (size_t)(row0 + ai * HALF + m * 16) * ldc + col0;
#pragma unroll
                for (int bj = 0; bj < 2; ++bj) { const f32x4 v0 = acc[ai][bj][m][0], v1 = acc[ai][bj][m][1];
                    u32x4 w; w.x = cvtpk(v0[0], v0[1]); w.y = cvtpk(v0[2], v0[3]); w.z = cvtpk(v1[0], v1[1]); w.w = cvtpk(v1[2], v1[3]);
                    *(u32x4*)(rowp + bj * HALF) = w; } }
    }
};
}

template <class F>
DI void skinny_gemm(LAS unsigned char* lds, const bf16* As, const bf16* Bt, int N, int K, int bid, int G, int tid, int wave, int lane, F epi) {
    asm volatile("" : "+v"(tid), "+v"(lane));
    LAS float* red = (LAS float*)lds;
    const int fr = lane & 15, fq = lane >> 4, kw = K / 8;
    for (int u = bid; u < N / 16; u += G) {
        f32x4 acc0 = {0.f, 0.f, 0.f, 0.f}, acc1 = {0.f, 0.f, 0.f, 0.f};
        const bf16* bp = Bt + (size_t)(u * 16 + fr) * K + wave * kw + 8 * fq;
        const bf16* a0 = As + (size_t)fr * K + wave * kw + 8 * fq; const bf16* a1 = a0 + (size_t)16 * K;
#pragma unroll 4
        for (int k = 0; k < kw; k += 32) { const bf16x8 bv = *(const GAS bf16x8*)(bp + k), x0 = *(const GAS bf16x8*)(a0 + k), x1 = *(const GAS bf16x8*)(a1 + k);
            acc0 = MFMA16(x0, bv, acc0); acc1 = MFMA16(x1, bv, acc1); }
        *(LAS f32x4*)(red + ((wave * 2 + 0) * 64 + lane) * 4) = acc0; *(LAS f32x4*)(red + ((wave * 2 + 1) * 64 + lane) * 4) = acc1;
        __syncthreads();
        { const int col = tid & 15, row = tid >> 4, mt = row >> 4, r16 = row & 15, ln = (r16 >> 2) * 16 + col, i = r16 & 3; float s = 0.f;
#pragma unroll
          for (int w = 0; w < 8; ++w) s += red[((w * 2 + mt) * 64 + ln) * 4 + i];
          epi(row, u * 16 + col, s); }
        __syncthreads();
    }
}

constexpr int XPI = 144, SX_OFF = 8192, SB_OFF = 81920, SC_OFF = 102400, BPI1 = 320, BPI3 = 272, CPI = 272;

template <bool SCALED>
DI void ssd_stage(const LA& A, LAS unsigned char* lds, int l, int b, int c, int g, int tid, int wave, int lane) {
    LAS float* s_dt = (LAS float*)lds; LAS float* s_cs = s_dt + 512;
    constexpr int BPI = SCALED ? BPI1 : BPI3;
    {   const int hh = g * 8 + wave; const int row = b * SEQ + c * CL + lane;
        const float raw = ((const float*)(A.W() + WS_DT))[(size_t)row * 16 + hh] + A.I(17)[l * NH + hh];
        const float dt = softplus_f(raw); const float a = -expf(A.I(18)[l * NH + hh]);
        const float cs = wave_incl_scan(dt * a, lane);
        s_dt[wave * 64 + lane] = dt; s_cs[wave * 64 + lane] = cs; }
    __syncthreads();
    const int cg = tid % 96, seg = tid / 96;
    if (tid < 384 && (!SCALED || cg < 80)) {
        int col;
        if (cg < 64) col = C_X + g * 512 + cg * 8; else if (cg < 80) col = C_B + g * 128 + (cg - 64) * 8; else col = C_C + g * 128 + (cg - 80) * 8;
        const int chx = col - 1024;
        float w[4][8], bias[8];
#pragma unroll
        for (int k = 0; k < 4; ++k) { const f32x4 a0 = *(const GAS f32x4*)(A.I(15) + ((size_t)l * 4 + k) * DXBC + chx), a1 = *(const GAS f32x4*)(A.I(15) + ((size_t)l * 4 + k) * DXBC + chx + 4);
            w[k][0] = a0.x; w[k][1] = a0.y; w[k][2] = a0.z; w[k][3] = a0.w; w[k][4] = a1.x; w[k][5] = a1.y; w[k][6] = a1.z; w[k][7] = a1.w; }
        { const f32x4 a0 = *(const GAS f32x4*)(A.I(16) + (size_t)l * DXBC + chx), a1 = *(const GAS f32x4*)(A.I(16) + (size_t)l * DXBC + chx + 4);
            bias[0] = a0.x; bias[1] = a0.y; bias[2] = a0.z; bias[3] = a0.w; bias[4] = a1.x; bias[5] = a1.y; bias[6] = a1.z; bias[7] = a1.w; }
        const bf16* proj = (const bf16*)(A.W() + WS_PROJ);
        const int t0 = c * CL + seg * 16;
        float win[3][8];
#pragma unroll
        for (int j = 0; j < 3; ++j) { const int t = t0 - 3 + j;
            if (t >= 0) { const v4u v = *(const GAS v4u*)(proj + (size_t)(b * SEQ + t) * PP + col); unpack8(v, win[j]); }
            else {
#pragma unroll
                for (int e = 0; e < 8; ++e) win[j][e] = 0.f; } }
        LAS unsigned char* dst; int pitch; int head = 0;
        if (cg < 64) { head = cg >> 3; dst = lds + SX_OFF + head * 64 * XPI + (cg & 7) * 16; pitch = XPI; }
        else if (cg < 80) { dst = lds + SB_OFF + (cg - 64) * 16; pitch = BPI; }
        else { dst = lds + SC_OFF + (cg - 80) * 16; pitch = CPI; }
        const float cs_end = s_cs[head * 64 + 63];
#pragma unroll
        for (int i = 0; i < 16; ++i) {
            const int ll = seg * 16 + i;
            float cur[8], o[8];
            { const v4u v = *(const GAS v4u*)(proj + (size_t)(b * SEQ + t0 + i) * PP + col); unpack8(v, cur); }
            float scale = 1.f;
            if (SCALED && cg < 64) scale = __expf(cs_end - s_cs[head * 64 + ll]) * s_dt[head * 64 + ll];
#pragma unroll
            for (int e = 0; e < 8; ++e) { const float y = bias[e] + w[0][e] * win[0][e] + w[1][e] * win[1][e] + w[2][e] * win[2][e] + w[3][e] * cur[e]; o[e] = silu_f(y) * scale;
                win[0][e] = win[1][e]; win[1][e] = win[2][e]; win[2][e] = cur[e]; }
            *(LAS v4u*)(dst + ll * pitch) = pack8(o);
        }
    }
    __syncthreads();
}

DI void ssd_chunk_state(const LA& A, LAS unsigned char* lds, int l, int u, int tid, int wave, int lane) {
    const int b = u >> 7, c = (u >> 1) & 63, g = u & 1;
    ssd_stage<true>(A, lds, l, b, c, g, tid, wave, lane);
    const int r = lane & 31, h = lane >> 5, blk = (lane >> 4) & 1, q = (lane & 15) >> 2, p4 = lane & 3;
    const LAS unsigned char* xb = lds + SX_OFF + wave * 64 * XPI + 32 * blk + 8 * p4;
    const LAS unsigned char* bb = lds + SB_OFF + 32 * blk + 8 * p4;
    f32x16 acc[4][2];
#pragma unroll
    for (int nt = 0; nt < 4; ++nt) { acc[nt][0] = zero16(); acc[nt][1] = zero16(); }
#pragma unroll
    for (int ks = 0; ks < 4; ++ks) {
        const int row0 = 16 * ks + 8 * h + q;
        bf16x8 af[4], bf[2];
#pragma unroll
        for (int nt = 0; nt < 4; ++nt) af[nt] = tr_pair(bb + row0 * BPI1 + nt * 64, bb + (row0 + 4) * BPI1 + nt * 64);
#pragma unroll
        for (int pt = 0; pt < 2; ++pt) bf[pt] = tr_pair(xb + row0 * XPI + pt * 64, xb + (row0 + 4) * XPI + pt * 64);
#pragma unroll
        for (int nt = 0; nt < 4; ++nt) { acc[nt][0] = MFMA32(af[nt], bf[0], acc[nt][0]); acc[nt][1] = MFMA32(af[nt], bf[1], acc[nt][1]); }
    }
    const int hh = g * 8 + wave;
    bf16* st = (bf16*)(A.W() + WS_ST) + ((size_t)((b * NCH + c) * NH + hh) * HP) * DST;
#pragma unroll
    for (int nt = 0; nt < 4; ++nt)
#pragma unroll
        for (int pt = 0; pt < 2; ++pt)
#pragma unroll
            for (int gq = 0; gq < 4; ++gq) { v2u pk; pk.x = cvtpk(acc[nt][pt][4 * gq], acc[nt][pt][4 * gq + 1]); pk.y = cvtpk(acc[nt][pt][4 * gq + 2], acc[nt][pt][4 * gq + 3]);
                *(GAS v2u*)(st + (size_t)(32 * pt + r) * DST + 32 * nt + 8 * gq + 4 * h) = pk; }
    if (lane == 0) ((float*)(A.W() + WS_DECAY))[(b * NCH + c) * NH + hh] = __expf(((LAS float*)lds)[512 + wave * 64 + 63]);
    __syncthreads();
}

DI void ssd_scan(const LA& A, int l, int bid, int G, int tid) {
    unsigned* st = (unsigned*)(A.W() + WS_ST); const float* dec = (const float*)(A.W() + WS_DECAY);
    for (int e = bid * NT + tid; e < NBP * NH * HP * (DST / 2); e += G * NT) {
        const int np = e & 63, p = (e >> 6) & 63, hh = (e >> 12) & 15, b = e >> 16;
        size_t idx = ((size_t)(b * NCH) * NH + hh) * (HP * DST / 2) + p * (DST / 2) + np;
        float h0 = 0.f, h1 = 0.f;
#pragma unroll 8
        for (int c = 0; c < NCH; ++c) { const unsigned s = st[idx]; const float d = dec[(b * NCH + c) * NH + hh]; st[idx] = cvtpk(h0, h1);
            h0 = d * h0 + bflo(s); h1 = d * h1 + bfhi(s); idx += (size_t)NH * (HP * DST / 2); }
        f32x2_t o = {h0, h1};
        *(GAS f32x2_t*)(A.O() + O_PSSM + ((size_t)((l * NBP + b) * NH + hh) * HP + p) * DST + 2 * np) = o;
    }
}

DI void ssd_chunk_out(const LA& A, LAS unsigned char* lds, int l, int u, int tid, int wave, int lane) {
    const int b = u >> 7, c = (u >> 1) & 63, g = u & 1;
    ssd_stage<false>(A, lds, l, b, c, g, tid, wave, lane);
    LAS float* s_dt = (LAS float*)lds; LAS float* s_cs = s_dt + 512; LAS float* s_ss = s_dt + 1024;
    const int r = lane & 31, h = lane >> 5, blk = (lane >> 4) & 1, q = (lane & 15) >> 2, p4 = lane & 3;
    const int hh = g * 8 + wave;
    const LAS unsigned char* bimg = lds + SB_OFF; const LAS unsigned char* cimg = lds + SC_OFF;
    const bf16* hs = (const bf16*)(A.W() + WS_ST) + ((size_t)((b * NCH + c) * NH + hh) * HP) * DST;
    f32x16 X0 = zero16(), X1 = zero16(), X2 = zero16(), Y00 = zero16(), Y01 = zero16(), Y10 = zero16(), Y11 = zero16();
#pragma unroll
    for (int ks = 0; ks < 8; ++ks) {
        const int ko = (16 * ks + 8 * h) * 2;
        const bf16x8 bs0 = *(const LAS bf16x8*)(bimg + r * BPI3 + ko), bs1 = *(const LAS bf16x8*)(bimg + (32 + r) * BPI3 + ko);
        const bf16x8 cl0 = *(const LAS bf16x8*)(cimg + r * CPI + ko), cl1 = *(const LAS bf16x8*)(cimg + (32 + r) * CPI + ko);
        const bf16x8 ha0 = *(const GAS bf16x8*)(hs + (size_t)r * DST + 16 * ks + 8 * h), ha1 = *(const GAS bf16x8*)(hs + (size_t)(32 + r) * DST + 16 * ks + 8 * h);
        X0 = MFMA32(bs0, cl0, X0); X1 = MFMA32(bs0, cl1, X1); X2 = MFMA32(bs1, cl1, X2);
        Y00 = MFMA32(ha0, cl0, Y00); Y01 = MFMA32(ha0, cl1, Y01); Y10 = MFMA32(ha1, cl0, Y10); Y11 = MFMA32(ha1, cl1, Y11);
        if (ks & 1) __builtin_amdgcn_sched_barrier(0);
    }
    const float csl0 = s_cs[wave * 64 + r], csl1 = s_cs[wave * 64 + 32 + r];
    { const float e0 = __expf(csl0), e1 = __expf(csl1);
#pragma unroll
      for (int i = 0; i < 16; ++i) { Y00[i] *= e0; Y10[i] *= e0; Y01[i] *= e1; Y11[i] *= e1; } }
#pragma unroll
    for (int gq = 0; gq < 4; ++gq) {
        const f32x4 csa = *(const LAS f32x4*)(s_cs + wave * 64 + 8 * gq + 4 * h), dta = *(const LAS f32x4*)(s_dt + wave * 64 + 8 * gq + 4 * h);
        const f32x4 csb = *(const LAS f32x4*)(s_cs + wave * 64 + 32 + 8 * gq + 4 * h), dtb = *(const LAS f32x4*)(s_dt + wave * 64 + 32 + 8 * gq + 4 * h);
#pragma unroll
        for (int e = 0; e < 4; ++e) { const int i = 4 * gq + e; const int s = 8 * gq + 4 * h + e;
            const float w0 = __expf(fminf(csl0 - csa[e], 0.f)) * dta[e], w1 = __expf(fminf(csl1 - csa[e], 0.f)) * dta[e], w2 = __expf(fminf(csl1 - csb[e], 0.f)) * dtb[e];
            X0[i] = (s <= r) ? X0[i] * w0 : 0.f; X1[i] = X1[i] * w1; X2[i] = (s <= r) ? X2[i] * w2 : 0.f; }
    }
    {   const LAS unsigned char* xb = lds + SX_OFF + wave * 64 * XPI + 32 * blk + 8 * p4;
#pragma unroll
        for (int ks2 = 0; ks2 < 2; ++ks2) {
            const bf16x8 W0 = pack_frag(X0, ks2), W1 = pack_frag(X1, ks2), W2 = pack_frag(X2, ks2);
            const int ra = 16 * ks2 + 4 * h + q, rb = 32 + 16 * ks2 + 4 * h + q;
            const bf16x8 xa0 = tr_pair(xb + ra * XPI, xb + (ra + 8) * XPI), xa1 = tr_pair(xb + ra * XPI + 64, xb + (ra + 8) * XPI + 64);
            const bf16x8 xc0 = tr_pair(xb + rb * XPI, xb + (rb + 8) * XPI), xc1 = tr_pair(xb + rb * XPI + 64, xb + (rb + 8) * XPI + 64);
            Y00 = MFMA32(xa0, W0, Y00); Y10 = MFMA32(xa1, W0, Y10);
            Y01 = MFMA32(xa0, W1, Y01); Y11 = MFMA32(xa1, W1, Y11);
            Y01 = MFMA32(xc0, W2, Y01); Y11 = MFMA32(xc1, W2, Y11);
        }
    }
    const float Dk = A.I(19)[l * NH + hh];
    const bf16* proj = (const bf16*)(A.W() + WS_PROJ);
    const LAS unsigned char* xrow = lds + SX_OFF + wave * 64 * XPI;
    float ss0 = 0.f, ss1 = 0.f;
#define SSD_EPI1(Y, pt, lt, ssv) do { const size_t zoff = (size_t)(b * SEQ + c * CL + 32 * (lt) + r) * PP + C_Z + hh * 64; \
        _Pragma("unroll") for (int gq = 0; gq < 4; ++gq) { const int p0 = 32 * (pt) + 8 * gq + 4 * h; \
            float xv[4], zv[4]; unpack4(*(const LAS v2u*)(xrow + (32 * (lt) + r) * XPI + p0 * 2), xv); unpack4(*(const GAS v2u*)(proj + zoff + p0), zv); \
            _Pragma("unroll") for (int e = 0; e < 4; ++e) { const float y = (Y[4 * gq + e] + Dk * xv[e]) * silu_f(zv[e]); Y[4 * gq + e] = y; ssv += y * y; } } } while (0)
    SSD_EPI1(Y00, 0, 0, ss0); SSD_EPI1(Y10, 1, 0, ss0); SSD_EPI1(Y01, 0, 1, ss1); SSD_EPI1(Y11, 1, 1, ss1);
#undef SSD_EPI1
    ss0 += __shfl_xor(ss0, 32); ss1 += __shfl_xor(ss1, 32);
    if (h == 0) { s_ss[wave * 64 + r] = ss0; s_ss[wave * 64 + 32 + r] = ss1; }
    __syncthreads();
    float t0 = 0.f, t1 = 0.f;
#pragma unroll
    for (int w = 0; w < 8; ++w) { t0 += s_ss[w * 64 + r]; t1 += s_ss[w * 64 + 32 + r]; }
    const float rs0 = 1.f / sqrtf(t0 * (1.f / 512.f) + EPS), rs1 = 1.f / sqrtf(t1 * (1.f / 512.f) + EPS);
    const float* nw = A.I(20) + (size_t)l * DSSD + hh * 64;
    bf16* mix = (bf16*)(A.W() + WS_MIX);
#define SSD_EPI2(Y, pt, lt, rs) do { bf16* op = mix + (size_t)(b * SEQ + c * CL + 32 * (lt) + r) * DM + hh * 64; \
        _Pragma("unroll") for (int gq = 0; gq < 4; ++gq) { const int p0 = 32 * (pt) + 8 * gq + 4 * h; const f32x4 wv = *(const GAS f32x4*)(nw + p0); \
            v2u pk; pk.x = cvtpk(Y[4 * gq] * rs * wv.x, Y[4 * gq + 1] * rs * wv.y); pk.y = cvtpk(Y[4 * gq + 2] * rs * wv.z, Y[4 * gq + 3] * rs * wv.w); *(GAS v2u*)(op + p0) = pk; } } while (0)
    SSD_EPI2(Y00, 0, 0, rs0); SSD_EPI2(Y10, 1, 0, rs0); SSD_EPI2(Y01, 0, 1, rs1); SSD_EPI2(Y11, 1, 1, rs1);
#undef SSD_EPI2
    __syncthreads();
}

constexpr int KPI = 144, VPI = 192, AK_OFF = 0, AV_OFF = 36864;
DI void attn_unit(const LA& A, LAS unsigned char* lds, int l, int u, int tid, int wave, int lane) {
    const int b = u >> 6, blk = (u >> 1) & 31, kvh = u & 1;
    const bf16* proj = (const bf16*)(A.W() + WS_PROJ);
    const float* rope = (const float*)(A.W() + WS_ROPE);
    {
        const int sub = tid & 7; const float* knw = A.I(22) + (size_t)l * HD;
        const f32x4 wlo = *(const GAS f32x4*)(knw + 4 * sub), whi = *(const GAS f32x4*)(knw + 32 + 4 * sub);
#pragma unroll
        for (int it = 0; it < 4; ++it) { const int j = it * 64 + (tid >> 3); const int t = (blk - 1) * 128 + j;
            float lo[4] = {0.f, 0.f, 0.f, 0.f}, hi[4] = {0.f, 0.f, 0.f, 0.f}; f32x4 cs0 = {1.f, 0.f, 1.f, 0.f}, cs1 = cs0;
            if (t >= 0) { const bf16* kp = proj + (size_t)(b * SEQ + t) * PP + C_K + kvh * 64 + 4 * sub; unpack4(*(const GAS v2u*)kp, lo); unpack4(*(const GAS v2u*)(kp + 32), hi);
                cs0 = *(const GAS f32x4*)(rope + ((size_t)t * 32 + 4 * sub) * 2); cs1 = *(const GAS f32x4*)(rope + ((size_t)t * 32 + 4 * sub) * 2 + 4); }
            float ss = (lo[0] * lo[0] + lo[1] * lo[1]) + (lo[2] * lo[2] + lo[3] * lo[3]) + (hi[0] * hi[0] + hi[1] * hi[1]) + (hi[2] * hi[2] + hi[3] * hi[3]);
            ss += __shfl_xor(ss, 1); ss += __shfl_xor(ss, 2); ss += __shfl_xor(ss, 4);
            const float rstd = 1.f / sqrtf(ss * (1.f / 64.f) + EPS);
            const float cc[4] = {cs0.x, cs0.z, cs1.x, cs1.z}, sn[4] = {cs0.y, cs0.w, cs1.y, cs1.w}; const float wl[4] = {wlo.x, wlo.y, wlo.z, wlo.w}, wh[4] = {whi.x, whi.y, whi.z, whi.w};
            float ol[4], oh[4];
#pragma unroll
            for (int e = 0; e < 4; ++e) { const float a = lo[e] * rstd * wl[e], bb = hi[e] * rstd * wh[e]; ol[e] = a * cc[e] - bb * sn[e]; oh[e] = bb * cc[e] + a * sn[e]; }
            v2u pl, ph; pl.x = cvtpk(ol[0], ol[1]); pl.y = cvtpk(ol[2], ol[3]); ph.x = cvtpk(oh[0], oh[1]); ph.y = cvtpk(oh[2], oh[3]);
            *(LAS v2u*)(lds + AK_OFF + j * KPI + 8 * sub) = pl; *(LAS v2u*)(lds + AK_OFF + j * KPI + 64 + 8 * sub) = ph;
            if (blk == 31 && j >= 128) { float* o = A.O() + O_PWK + ((size_t)((l * NBP + b) * WIN + (j - 128)) * NKV + kvh) * HD;
                f32x4 v0 = {ol[0], ol[1], ol[2], ol[3]}, v1 = {oh[0], oh[1], oh[2], oh[3]}; *(GAS f32x4*)(o + 4 * sub) = v0; *(GAS f32x4*)(o + 32 + 4 * sub) = v1; }
        }
#pragma unroll
        for (int it = 0; it < 4; ++it) { const int idx = tid + NT * it; const int j = idx >> 3, ch = idx & 7; const int t = (blk - 1) * 128 + j;
            v4u v = {0u, 0u, 0u, 0u};
            if (t >= 0) v = *(const GAS v4u*)(proj + (size_t)(b * SEQ + t) * PP + C_V + kvh * 64 + 8 * ch);
            *(LAS v4u*)(lds + AV_OFF + j * VPI + 16 * ch) = v;
            if (blk == 31 && j >= 128) { float f[8]; unpack8(v, f); float* o = A.O() + O_PWV + ((size_t)((l * NBP + b) * WIN + (j - 128)) * NKV + kvh) * HD + 8 * ch;
                f32x4 v0 = {f[0], f[1], f[2], f[3]}, v1 = {f[4], f[5], f[6], f[7]}; *(GAS f32x4*)o = v0; *(GAS f32x4*)(o + 4) = v1; }
        }
    }
    __syncthreads();
    const int r = lane & 31, h = lane >> 5, blkl = (lane >> 4) & 1, q = (lane & 15) >> 2, p4 = lane & 3;
    const int qh = wave >> 1, half = wave & 1, head = kvh * 4 + qh;
    const float sink = A.I(23)[l * NQH + head];
    const float* qnw = A.I(21) + (size_t)l * HD;
    bf16* mix = (bf16*)(A.W() + WS_MIX);
#pragma unroll 1
    for (int tt = 0; tt < 2; ++tt) {
        const int tq = 2 * half + tt; const int tok = blk * 128 + 32 * tq + r; const size_t row = (size_t)b * SEQ + tok;
        float qf[4][8]; float ss = 0.f;
#pragma unroll
        for (int ks = 0; ks < 4; ++ks) { unpack8(*(const GAS v4u*)(proj + row * PP + C_Q + head * 64 + 16 * ks + 8 * h), qf[ks]);
#pragma unroll
            for (int e = 0; e < 8; ++e) ss += qf[ks][e] * qf[ks][e]; }
        ss += __shfl_xor(ss, 32);
        const float rstd = 0.125f / sqrtf(ss * (1.f / 64.f) + EPS);
        bf16x8 qb[4];
        {   float o[4][8];
#pragma unroll
            for (int ks = 0; ks < 2; ++ks) {
#pragma unroll
                for (int e = 0; e < 8; ++e) { const int d = 16 * ks + 8 * h + e; const f32x2_t cs = *(const GAS f32x2_t*)(rope + ((size_t)tok * 32 + d) * 2);
                    const float a = qf[ks][e] * rstd * qnw[d], bb = qf[ks + 2][e] * rstd * qnw[d + 32]; o[ks][e] = a * cs.x - bb * cs.y; o[ks + 2][e] = bb * cs.x + a * cs.y; } }
#pragma unroll
            for (int ks = 0; ks < 4; ++ks) qb[ks] = __builtin_bit_cast(bf16x8, pack8(o[ks]));
        }
        f32x16 S[5];
#pragma unroll
        for (int jj = 0; jj < 5; ++jj) { S[jj] = zero16();
#pragma unroll
            for (int ks = 0; ks < 4; ++ks) { const bf16x8 ka = *(const LAS bf16x8*)(lds + AK_OFF + (32 * (tq + jj) + r) * KPI + (16 * ks + 8 * h) * 2); S[jj] = MFMA32(ka, qb[ks], S[jj]); }
            __builtin_amdgcn_sched_barrier(0); }
        float m = sink;
#pragma unroll
        for (int jj = 0; jj < 5; ++jj)
#pragma unroll
            for (int i = 0; i < 16; ++i) { const int dj = 32 * jj + crow(i, h) - r; const bool ok = dj >= 0 && dj <= WIN && (blk > 0 || 32 * (tq + jj) >= 128);
                S[jj][i] = ok ? S[jj][i] : -1e30f; m = fmaxf(m, S[jj][i]); }
        m = fmaxf(m, __shfl_xor(m, 32));
        float sum = 0.f;
#pragma unroll
        for (int jj = 0; jj < 5; ++jj)
#pragma unroll
            for (int i = 0; i < 16; ++i) { const float p = __expf(S[jj][i] - m); S[jj][i] = p; sum += p; }
        sum += __shfl_xor(sum, 32);
        const float inv = 1.f / (sum + __expf(sink - m));
        __builtin_amdgcn_sched_barrier(0);
        f32x16 O0 = zero16(), O1 = zero16();
        const LAS unsigned char* vb = lds + AV_OFF + 32 * blkl + 8 * p4;
#pragma unroll
        for (int jj = 0; jj < 5; ++jj)
#pragma unroll
            for (int ks2 = 0; ks2 < 2; ++ks2) { const bf16x8 pb = pack_frag(S[jj], ks2); const int jr = 32 * (tq + jj) + 16 * ks2 + 4 * h + q;
                const bf16x8 va0 = tr_pair(vb + jr * VPI, vb + (jr + 8) * VPI), va1 = tr_pair(vb + jr * VPI + 64, vb + (jr + 8) * VPI + 64);
                O0 = MFMA32(va0, pb, O0); O1 = MFMA32(va1, pb, O1); __builtin_amdgcn_sched_barrier(0); }
        bf16* op = mix + row * DM + DSSD + head * 64;
#pragma unroll
        for (int gq = 0; gq < 4; ++gq) { v2u pk; pk.x = cvtpk(O0[4 * gq] * inv, O0[4 * gq + 1] * inv); pk.y = cvtpk(O0[4 * gq + 2] * inv, O0[4 * gq + 3] * inv); *(GAS v2u*)(op + 8 * gq + 4 * h) = pk;
            pk.x = cvtpk(O1[4 * gq] * inv, O1[4 * gq + 1] * inv); pk.y = cvtpk(O1[4 * gq + 2] * inv, O1[4 * gq + 3] * inv); *(GAS v2u*)(op + 32 + 8 * gq + 4 * h) = pk; }
    }
    __syncthreads();
}

DI void samp_ssd_unit(const LA& A, LAS unsigned char* lds, int l, int u, int tid, int wave, int lane) {
    const int sb = u >> 1, g = u & 1;
    LAS float* xs = (LAS float*)lds; LAS float* Bv = xs + 512; LAS float* Cv = Bv + 128; LAS float* s_ss = Cv + 128;
    const PSrow ps{(const bf16*)(A.W() + WS_PROJ) + (size_t)(MP + sb) * PP, (const float*)(A.W() + WS_DT) + (size_t)(MP + sb) * 16};
    for (int ci = tid; ci < 768; ci += NT) {
        const int chx = ci < 512 ? g * 512 + ci : (ci < 640 ? 1024 + g * 128 + (ci - 512) : 1280 + g * 128 + (ci - 640));
        const float nr = ps[1024 + chx];
        const float* sp = A.I(3) + ((size_t)(l * MS + sb) * 3) * DXBC + chx;
        const float p0 = sp[0], p1 = sp[DXBC], p2 = sp[2 * DXBC];
        const float* cw = A.I(15) + (size_t)l * 4 * DXBC + chx;
        const float v = silu_f(A.I(16)[(size_t)l * DXBC + chx] + cw[0] * p0 + cw[DXBC] * p1 + cw[2 * DXBC] * p2 + cw[3 * DXBC] * nr);
        float* so = A.O() + O_SSSMCONV + ((size_t)(l * MS + sb) * 3) * DXBC + chx;
        so[0] = p1; so[DXBC] = p2; so[2 * DXBC] = nr;
        xs[ci] = v;
    }
    __syncthreads();
    const int hh = g * 8 + wave;
    const float dt = softplus_f(ps[C_DT + hh] + A.I(17)[l * NH + hh]);
    const float dA = expf(dt * -expf(A.I(18)[l * NH + hh]));
    const float Dk = A.I(19)[l * NH + hh];
    const size_t hoff = ((size_t)((l * MS + sb) * NH + hh) * HP) * DST;
    const float* h0 = A.I(2) + hoff; float* ho = A.O() + O_SSSM + hoff;
    const float b0 = Bv[2 * lane], b1 = Bv[2 * lane + 1], c0 = Cv[2 * lane], c1 = Cv[2 * lane + 1];
    float ymine = 0.f;
#pragma unroll 4
    for (int p = 0; p < HP; ++p) { const float xp = xs[wave * 64 + p]; const f32x2_t hv = *(const GAS f32x2_t*)(h0 + p * DST + 2 * lane);
        f32x2_t hn; hn.x = dA * hv.x + dt * xp * b0; hn.y = dA * hv.y + dt * xp * b1; *(GAS f32x2_t*)(ho + p * DST + 2 * lane) = hn;
        const float part = wave_sum(c0 * hn.x + c1 * hn.y); if (lane == p) ymine = part + Dk * xp; }
    const float y = ymine * silu_f(ps[C_Z + hh * 64 + lane]);
    const float ssq = wave_sum(y * y);
    if (lane == 0) s_ss[wave] = ssq;
    __syncthreads();
    float tot = 0.f;
#pragma unroll
    for (int w = 0; w < 8; ++w) tot += s_ss[w];
    const float rstd = 1.f / sqrtf(tot * (1.f / 512.f) + EPS);
    const float o = y * rstd * A.I(20)[(size_t)l * DSSD + hh * 64 + lane];
    ((bf16*)(A.W() + WS_MIX))[(size_t)(MP + sb) * DM + hh * 64 + lane] = (bf16)(cvtpk(o, 0.f) & 0xffffu);
    __syncthreads();
}

DI void samp_attn_unit(const LA& A, LAS unsigned char* lds, int l, int u, int tid, int wave, int lane) {
    const int sb = u >> 1, kvh = u & 1;
    LAS float* s_q = (LAS float*)lds;
    LAS float* s_k = s_q + 256;
    LAS float* s_v = s_k + 64;
    LAS float* s_p = s_v + 64;
    const PSrow ps{(const bf16*)(A.W() + WS_PROJ) + (size_t)(MP + sb) * PP, (const float*)(A.W() + WS_DT) + (size_t)(MP + sb) * 16};
    const float* rope = (const float*)(A.W() + WS_ROPE) + (size_t)4096 * 64;
    if (wave < 5) {
        const int col = wave < 4 ? C_Q + (kvh * 4 + wave) * 64 : C_K + kvh * 64;
        const float x = ps[col + lane];
        const float rstd = 1.f / sqrtf(wave_sum(x * x) * (1.f / 64.f) + EPS);
        const float w = (wave < 4 ? A.I(21) : A.I(22))[(size_t)l * HD + lane];
        const float xn = x * rstd * w; const float other = __shfl_xor(xn, 32);
        const int i = lane & 31; const float cs = rope[2 * i], sn = rope[2 * i + 1];
        const float o = lane < 32 ? xn * cs - other * sn : xn * cs + other * sn;
        if (wave < 4) s_q[wave * 64 + lane] = o * 0.125f; else s_k[lane] = o;
    } else if (wave == 5) s_v[lane] = ps[C_V + kvh * 64 + lane];
    __syncthreads();
    const float* kc = A.I(4) + ((size_t)(l * MS + sb) * WIN) * (NKV * HD) + kvh * HD;
    const float* vc = A.I(5) + ((size_t)(l * MS + sb) * WIN) * (NKV * HD) + kvh * HD;
    if (wave < 4) {
        const int head = kvh * 4 + wave; const float sink = A.I(23)[l * NQH + head];
        float s0 = 0.f, s1 = 0.f, s2 = 0.f;
        const float* k0 = kc + (size_t)lane * (NKV * HD); const float* k1 = kc + (size_t)(lane + 64) * (NKV * HD);
#pragma unroll
        for (int d4 = 0; d4 < 16; ++d4) { const f32x4 qv = *(const LAS f32x4*)(s_q + wave * 64 + 4 * d4); const f32x4 a = *(const GAS f32x4*)(k0 + 4 * d4), bq = *(const GAS f32x4*)(k1 + 4 * d4); const f32x4 kn = *(const LAS f32x4*)(s_k + 4 * d4);
            s0 += (qv.x * a.x + qv.y * a.y) + (qv.z * a.z + qv.w * a.w); s1 += (qv.x * bq.x + qv.y * bq.y) + (qv.z * bq.z + qv.w * bq.w); s2 += (qv.x * kn.x + qv.y * kn.y) + (qv.z * kn.z + qv.w * kn.w); }
        float m = fmaxf(fmaxf(s0, s1), fmaxf(s2, sink)); m = wave_max(m);
        const float p0 = __expf(s0 - m), p1 = __expf(s1 - m), p2 = __expf(s2 - m);
        const float den = wave_sum(p0 + p1) + p2 + __expf(sink - m);
        const float inv = 1.f / den;
        s_p[wave * 132 + lane] = p0 * inv; s_p[wave * 132 + 64 + lane] = p1 * inv; if (lane == 0) s_p[wave * 132 + 128] = p2 * inv;
        LDS_WAIT(); asm volatile("" ::: "memory");
        float o = s_p[wave * 132 + 128] * s_v[lane];
#pragma unroll 8
        for (int j = 0; j < WIN; ++j) o += s_p[wave * 132 + j] * vc[(size_t)j * (NKV * HD) + lane];
        ((bf16*)(A.W() + WS_MIX))[(size_t)(MP + sb) * DM + DSSD + head * 64 + lane] = (bf16)(cvtpk(o, 0.f) & 0xffffu);
    } else {
        float* ok = A.O() + O_SWK + ((size_t)(l * MS + sb) * WIN) * (NKV * HD) + kvh * HD;
        float* ov = A.O() + O_SWV + ((size_t)(l * MS + sb) * WIN) * (NKV * HD) + kvh * HD;
        for (int j = wave - 4; j < WIN; j += 4) {
            const float kv = j < WIN - 1 ? kc[(size_t)(j + 1) * (NKV * HD) + lane] : s_k[lane];
            const float vv = j < WIN - 1 ? vc[(size_t)(j + 1) * (NKV * HD) + lane] : s_v[lane];
            ok[(size_t)j * (NKV * HD) + lane] = kv; ov[(size_t)j * (NKV * HD) + lane] = vv; }
    }
    __syncthreads();
}

DI void samp_sconv_unit(const LA& A, int l, int u, int tid) {
    for (int i = tid; i < 4 * DCONV; i += NT) { const int sb = u * 4 + (i >> 9), ch = i & 511;
        const PSrow ps{(const bf16*)(A.W() + WS_PROJ) + (size_t)(MP + sb) * PP, (const float*)(A.W() + WS_DT) + (size_t)(MP + sb) * 16};
        const float vn = ps[C_GC + ch] * ps[C_HC + ch];
        const float* sp = A.I(6) + ((size_t)(l * MS + sb) * 2) * DCONV + ch; const float p0 = sp[0], p1 = sp[DCONV];
        const float* cw = A.I(24) + (size_t)l * 3 * DCONV + ch;
        const float y = ps[C_GB + ch] * (cw[0] * p0 + cw[DCONV] * p1 + cw[2 * DCONV] * vn);
        ((bf16*)(A.W() + WS_MIX))[(size_t)(MP + sb) * DM + 1536 + ch] = (bf16)(cvtpk(y, 0.f) & 0xffffu);
        float* so = A.O() + O_SSC + ((size_t)(l * MS + sb) * 2) * DCONV + ch; so[0] = p1; so[DCONV] = vn; }
}

DI void sconv_unit(const LA& A, int l, int u, int tid) {
    const int b = u >> 6, tile = u & 63, cg = tid & 63, seg = tid >> 6;
    const bf16* proj = (const bf16*)(A.W() + WS_PROJ); bf16* mix = (bf16*)(A.W() + WS_MIX);
    const int t0 = tile * 64 + seg * 8, ch = cg * 8;
    float w[3][8];
#pragma unroll
    for (int k = 0; k < 3; ++k) { const f32x4 a0 = *(const GAS f32x4*)(A.I(24) + ((size_t)l * 3 + k) * DCONV + ch), a1 = *(const GAS f32x4*)(A.I(24) + ((size_t)l * 3 + k) * DCONV + ch + 4);
        w[k][0] = a0.x; w[k][1] = a0.y; w[k][2] = a0.z; w[k][3] = a0.w; w[k][4] = a1.x; w[k][5] = a1.y; w[k][6] = a1.z; w[k][7] = a1.w; }
    float win[2][8];
#pragma unroll
    for (int j = 0; j < 2; ++j) { const int t = t0 - 2 + j;
        if (t >= 0) { float gc[8], hc[8]; const bf16* rp = proj + (size_t)(b * SEQ + t) * PP; unpack8(*(const GAS v4u*)(rp + C_GC + ch), gc); unpack8(*(const GAS v4u*)(rp + C_HC + ch), hc);
#pragma unroll
            for (int e = 0; e < 8; ++e) win[j][e] = gc[e] * hc[e]; }
        else {
#pragma unroll
            for (int e = 0; e < 8; ++e) win[j][e] = 0.f; } }
#pragma unroll
    for (int i = 0; i < 8; ++i) { const int t = t0 + i; const bf16* rp = proj + (size_t)(b * SEQ + t) * PP;
        float gc[8], hc[8], gb[8], o[8]; unpack8(*(const GAS v4u*)(rp + C_GC + ch), gc); unpack8(*(const GAS v4u*)(rp + C_HC + ch), hc); unpack8(*(const GAS v4u*)(rp + C_GB + ch), gb);
#pragma unroll
        for (int e = 0; e < 8; ++e) { const float v = gc[e] * hc[e]; o[e] = gb[e] * (w[0][e] * win[0][e] + w[1][e] * win[1][e] + w[2][e] * v); win[0][e] = win[1][e]; win[1][e] = v; }
        *(GAS v4u*)(mix + (size_t)(b * SEQ + t) * DM + 1536 + ch) = pack8(o); }
    if (tile == 63 && seg == 7) { float* so = A.O() + O_PSC + ((size_t)(l * NBP + b) * 2) * DCONV + ch;
#pragma unroll
        for (int e = 0; e < 8; ++e) { so[e] = win[0][e]; so[DCONV + e] = win[1][e]; } }
    if (tile == 63) { float* so = A.O() + O_PSSMCONV + ((size_t)(l * NBP + b) * 3) * DXBC;
        for (int i = tid; i < 3 * DXBC; i += NT) { const int rr = i / DXBC, cx = i % DXBC; const unsigned short v = proj[(size_t)(b * SEQ + SEQ - 3 + rr) * PP + 1024 + cx]; so[i] = __uint_as_float((unsigned)v << 16); } }
}

DI void act_unit(const LA& A, int l, int u, int tid) {
    const int cb = u % 11, tile = (u / 11) & 63, b = u / (11 * 64), cg = tid & 63, seg = tid >> 6;
    const bf16* gu = (const bf16*)(A.W() + WS_GU); bf16* act = (bf16*)(A.W() + WS_ACT);
    const int t0 = tile * 64 + seg * 8, ch = cb * 512 + cg * 8;
    float w[3][8], bias[8];
#pragma unroll
    for (int k = 0; k < 3; ++k) { const f32x4 a0 = *(const GAS f32x4*)(A.I(27) + ((size_t)l * 3 + k) * DFF + ch), a1 = *(const GAS f32x4*)(A.I(27) + ((size_t)l * 3 + k) * DFF + ch + 4);
        w[k][0] = a0.x; w[k][1] = a0.y; w[k][2] = a0.z; w[k][3] = a0.w; w[k][4] = a1.x; w[k][5] = a1.y; w[k][6] = a1.z; w[k][7] = a1.w; }
    { const f32x4 a0 = *(const GAS f32x4*)(A.I(28) + (size_t)l * DFF + ch), a1 = *(const GAS f32x4*)(A.I(28) + (size_t)l * DFF + ch + 4);
        bias[0] = a0.x; bias[1] = a0.y; bias[2] = a0.z; bias[3] = a0.w; bias[4] = a1.x; bias[5] = a1.y; bias[6] = a1.z; bias[7] = a1.w; }
    float win[2][8];
#pragma unroll
    for (int j = 0; j < 2; ++j) { const int t = t0 - 2 + j;
        if (t >= 0) unpack8(*(const GAS v4u*)(gu + (size_t)(b * SEQ + t) * (2 * DFF) + ch), win[j]);
        else {
#pragma unroll
            for (int e = 0; e < 8; ++e) win[j][e] = 0.f; } }
#pragma unroll
    for (int i = 0; i < 8; ++i) { const int t = t0 + i; const bf16* rp = gu + (size_t)(b * SEQ + t) * (2 * DFF) + ch;
        float gt[8], uu[8], o[8]; unpack8(*(const GAS v4u*)rp, gt); unpack8(*(const GAS v4u*)(rp + DFF), uu);
#pragma unroll
        for (int e = 0; e < 8; ++e) { o[e] = silu_f(bias[e] + w[0][e] * win[0][e] + w[1][e] * win[1][e] + w[2][e] * gt[e]) * uu[e]; win[0][e] = win[1][e]; win[1][e] = gt[e]; }
        *(GAS v4u*)(act + (size_t)(b * SEQ + t) * DFF + ch) = pack8(o); }
    if (tile == 63 && seg == 7) { float* so = A.O() + O_PFC + ((size_t)(l * NBP + b) * 2) * DFF + ch;
#pragma unroll
        for (int e = 0; e < 8; ++e) { so[e] = win[0][e]; so[DFF + e] = win[1][e]; } }
}
DI void samp_act_unit(const LA& A, int l, int sb, int tid) {
    const GSrow gs{(const bf16*)(A.W() + WS_GU) + (size_t)(MP + sb) * (2 * DFF)};
    for (int j = tid; j < DFF; j += NT) { const float gn = gs[j], un = gs[DFF + j];
        const float* sp = A.I(7) + ((size_t)(l * MS + sb) * 2) * DFF + j; const float p0 = sp[0], p1 = sp[DFF];
        const float* cw = A.I(27) + (size_t)l * 3 * DFF + j;
        const float o = silu_f(A.I(28)[(size_t)l * DFF + j] + cw[0] * p0 + cw[DFF] * p1 + cw[2 * DFF] * gn) * un;
        ((bf16*)(A.W() + WS_ACT))[(size_t)(MP + sb) * DFF + j] = (bf16)(cvtpk(o, 0.f) & 0xffffu);
        float* so = A.O() + O_SFC + ((size_t)(l * MS + sb) * 2) * DFF + j; so[0] = p1; so[DFF] = gn; }
}

#ifndef PHMASK
#define PHMASK 0xffffffffu
#endif
#define EN(k) ((((unsigned)(PHMASK)) >> (k)) & 1u)
__global__ void __launch_bounds__(NT, 2) hymba_fwd(Args KA) {
    extern __shared__ __attribute__((aligned(16))) unsigned char lds_raw[];
    LAS unsigned char* lds = (LAS unsigned char*)lds_raw;
    const int G = gridDim.x, bid = blockIdx.x, NGW = G * NWAVES;
#define IDS() int tid_ = threadIdx.x; asm volatile("" : "+v"(tid_)); const int tid = tid_, lane = tid & 63, wave = __builtin_amdgcn_readfirstlane(tid >> 6), gw = bid * NWAVES + wave; (void)lane; (void)gw
    volatile LAS unsigned* MISC = (volatile LAS unsigned*)(lds + MISC_OFF);
    for (int u = threadIdx.x; u < (LDS_BYTES - LDSCTL_OFF) / 4; u += NT) ((LAS unsigned*)(lds + LDSCTL_OFF))[u] = 0u;
    __syncthreads();
    if (threadIdx.x < 32) { const int i = threadIdx.x; const unsigned long long v = i < 30 ? (unsigned long long)KA.in[i] : (i == 30 ? (unsigned long long)KA.out : (unsigned long long)KA.ws);
        *(LAS unsigned long long*)(lds + LARGS_OFF + 8 * i) = v; }
    __syncthreads();
    const LA A{};
    (void)xcd_barrier_post((unsigned*)(KA.ws + WS_CTL) + CW_BAR, MISC + 8);
#define GRID_BAR() do { XcdBarrier b_; b_.bar = (unsigned*)(A.W() + WS_CTL) + CW_BAR; b_.x = xb_xcc_id(); b_.st = MISC + 8; xcd_barrier(b_); } while (0)

    if (EN(0)) { IDS(); p0_rope(A, bid * NT + tid, G * NT); }
    if (EN(1)) { IDS(); p0_mod(A, lds, bid, G, tid, wave, lane); }
    if (EN(2)) { IDS(); p0_weights(A, lds, gw, NGW, wave, lane); }
    GRID_BAR();

#pragma unroll 1
    for (int l = 0; l < DEPTH; ++l) {
        const float* modl = (const float*)(A.W() + WS_MOD) + (size_t)l * NMR * NMOD;
        const float* xin_p = l == 0 ? A.I(0) : A.O() + O_YP;
        const float* xin_s = l == 0 ? A.I(1) : A.O() + O_YS;
        if (EN(3)) { IDS(); phase_norm(A, l, 0, gw, NGW, lane); }
        GRID_BAR();
        if (EN(4)) {   pg8::Gemm g{(const bf16*)(A.W() + WS_HA), (const bf16*)(A.W() + WS_WIN) + (size_t)l * NPROJ * DM, MPAD, NPROJ, DM}; pg8::StaticOrder S; S.init(MPAD, NPROJ, G, bid);
            pg8::EpiProj E{(bf16*)(A.W() + WS_PROJ), (float*)(A.W() + WS_DT)};
            pg8::gemm_phase<pg8::EpiProj, pg8::StaticOrder, PG8_ALIGN, PG8_SP2>(lds + RING_OFF, g, S, E);
        }
        GRID_BAR();
        if (EN(6)) { IDS(); for (int u = bid; u < NBP * NCH * 2; u += G) ssd_chunk_state(A, lds, l, u, tid, wave, lane); }
        GRID_BAR();
        if (EN(7)) { IDS(); ssd_scan(A, l, bid, G, tid); }
        for (int u = bid; u < 128 + 128 + 64 + 64 + 8; u += G) { IDS();
            if (u < 128) { if (EN(8)) attn_unit(A, lds, l, u, tid, wave, lane); }
            else if (u < 256) { if (EN(9)) sconv_unit(A, l, u - 128, tid); }
            else if (u < 320) { if (EN(10)) samp_ssd_unit(A, lds, l, u - 256, tid, wave, lane); }
            else if (u < 384) { if (EN(11)) samp_attn_unit(A, lds, l, u - 320, tid, wave, lane); }
            else { if (EN(12)) samp_sconv_unit(A, l, u - 384, tid); }
        }
        GRID_BAR();
        if (EN(13)) { IDS(); for (int u = bid; u < NBP * NCH * 2; u += G) ssd_chunk_out(A, lds, l, u, tid, wave, lane); }
        GRID_BAR();
        if (EN(14)) {   pg8::Gemm g{(const bf16*)(A.W() + WS_MIX), (const bf16*)(A.W() + WS_WOUT) + (size_t)l * DM * DM, MP, DM, DM}; pg8::StaticOrder S; S.init(MP, DM, G, bid);
            pg8::EpiResid E{xin_p, A.O() + O_YP, modl + 2 * DM};
            pg8::gemm_phase<pg8::EpiResid, pg8::StaticOrder, PG8_ALIGN, PG8_SP2>(lds + RING_OFF, g, S, E);
            float* xo = A.O() + O_YS; const float* gate = modl + 2 * NMOD + 2 * DM; IDS();
            skinny_gemm(lds, (const bf16*)(A.W() + WS_MIX) + (size_t)MP * DM, g.Bt, DM, DM, bid, G, tid, wave, lane, [=](int row, int col, float v) { xo[(size_t)row * DM + col] = xin_s[(size_t)row * DM + col] + gate[(size_t)row * NMOD + col] * v; });
        }
        GRID_BAR();
        if (EN(15)) { IDS(); phase_norm(A, l, 1, gw, NGW, lane); }
        GRID_BAR();
        if (EN(16)) {   pg8::Gemm g{(const bf16*)(A.W() + WS_HA), (const bf16*)(A.W() + WS_WUP) + (size_t)l * 2 * DFF * DM, MPAD, 2 * DFF, DM}; pg8::StaticOrder S; S.init(MPAD, 2 * DFF, G, bid);
            pg8::EpiPlain E{(bf16*)(A.W() + WS_GU), 2 * DFF};
            pg8::gemm_phase<pg8::EpiPlain, pg8::StaticOrder, PG8_ALIGN, PG8_SP2>(lds + RING_OFF, g, S, E);
        }
        GRID_BAR();
        if (EN(17)) for (int u = bid; u < NBP * 64 * 11 + MS; u += G) { IDS(); if (u < NBP * 64 * 11) act_unit(A, l, u, tid); else samp_act_unit(A, l, u - NBP * 64 * 11, tid); }
        GRID_BAR();
        if (EN(18)) {   pg8::Gemm g{(const bf16*)(A.W() + WS_ACT), (const bf16*)(A.W() + WS_WDN) + (size_t)l * DM * DFF, MP, DM, DFF}; pg8::StaticOrder S; S.init(MP, DM, G, bid);
            pg8::EpiResid E{A.O() + O_YP, A.O() + O_YP, modl + 5 * DM};
            pg8::gemm_phase<pg8::EpiResid, pg8::StaticOrder, PG8_ALIGN, PG8_SP2>(lds + RING_OFF, g, S, E);
            float* xo = A.O() + O_YS; const float* gate = modl + 2 * NMOD + 5 * DM; IDS();
            if (EN(19)) skinny_gemm(lds, (const bf16*)(A.W() + WS_ACT) + (size_t)MP * DFF, g.Bt, DM, DFF, bid, G, tid, wave, lane, [=](int row, int col, float v) { xo[(size_t)row * DM + col] += gate[(size_t)row * NMOD + col] * v; });
        }
        if (l + 1 < DEPTH) GRID_BAR();
    }
}

extern "C" void kernel_launch(void* const* d_in, const int* in_sizes, int n_in, void* d_out, int out_size, void* d_ws, size_t ws_size, hipStream_t stream) {
    static int grid = 0;
    if (grid == 0) {
        if (n_in != 30 || (size_t)out_size != O_END || ws_size < WS_END) { fprintf(stderr, "kernel_launch: unexpected shapes (n_in %d, out %d, ws %zu)\n", n_in, out_size, ws_size); grid = -1; return; }
        int dev = 0, cus = 0, per_cu = 0;
        if (hipGetDevice(&dev) != hipSuccess || hipDeviceGetAttribute(&cus, hipDeviceAttributeMultiprocessorCount, dev) != hipSuccess) { grid = -1; return; }
        if (hipFuncSetAttribute((const void*)hymba_fwd, hipFuncAttributeMaxDynamicSharedMemorySize, LDS_BYTES) != hipSuccess) { fprintf(stderr, "kernel_launch: hipFuncSetAttribute failed\n"); grid = -1; return; }
        if (hipOccupancyMaxActiveBlocksPerMultiprocessor(&per_cu, (const void*)hymba_fwd, NT, LDS_BYTES) != hipSuccess || per_cu < 1) { fprintf(stderr, "kernel_launch: occupancy query says %d blocks per CU\n", per_cu); }
        (void)hipGetLastError();
        grid = cus;
    }
    if (grid < 0) return;
    if (hipMemsetAsync((char*)d_ws + WS_CTL, 0, CTL_ZERO_BYTES, stream) != hipSuccess) return;
    Args a{};
    for (int i = 0; i < 30; ++i) a.in[i] = (const float*)d_in[i];
    a.out = (float*)d_out; a.ws = (unsigned char*)d_ws;
    hipLaunchKernelGGL(hymba_fwd, dim3(grid), dim3(NT), LDS_BYTES, stream, a);
    const hipError_t le = hipPeekAtLastError();
    if (le != hipSuccess) fprintf(stderr, "kernel_launch: launch failed: %s\n", hipGetErrorName(le));
}
```

```cpp
#include <hip/hip_runtime.h>
#include <cstdio>
#include <cstdint>
namespace pg8 {
#define PG8_LAS __attribute__((address_space(3)))
typedef unsigned short bf16_t;
typedef short bf16x8 __attribute__((ext_vector_type(8)));
typedef float f32x4 __attribute__((ext_vector_type(4)));
typedef unsigned u32x4 __attribute__((ext_vector_type(4)));
constexpr int BM = 256, BK = 64, HALF = 128, HTB = HALF * BK * 2  , STAGE_BYTES = 8 * HTB, NXCD = 8, WGM = 8;

__host__ __device__ __forceinline__ int lds_byte(int r, int c) { const int st = (r >> 4) * 2 + (c >> 5), rr = r & 15, cc = c & 31, ob = rr * 64 + cc * 2; return st * 1024 + (ob ^ (((ob >> 9) & 1) << 5)); }
__host__ __device__ __forceinline__ void stage_rc(int b, int& R, int& C) { const int st = b / 1024, sb = b % 1024, swz = sb ^ (((sb >> 9) & 1) << 5); R = (st >> 1) * 16 + swz / 64; C = (st & 1) * 32 + (swz % 64) / 2; }
__host__ __device__ __forceinline__ int perm32(int rho) { const int n = rho >> 4, i = rho & 15; return 8 * (i >> 2) + 4 * n + (i & 3); }

struct Unit { int pm, pn; };
struct Gemm { const bf16_t* A; const bf16_t* Bt; int M, N, K; };

struct StaticOrder {
    int nM, nN, nwg, G, c;
    __host__ __device__ void init(int M, int N, int G_, int c_) { nM = M / BM; nN = N / BM; nwg = nM * nN; G = G_; c = c_; }
    __host__ __device__ bool next(int i, Unit& u) const {
        const long L = (long)i * G + c; if (L >= nwg) return false;
        int wgid = (int)L; { const int q = nwg / NXCD, r = nwg % NXCD, xcd = wgid % NXCD, off = wgid / NXCD; wgid = (xcd < r ? xcd * (q + 1) : r * (q + 1) + (xcd - r) * q) + off; }
        const int nig = WGM * nN, gid = wgid / nig, fm = gid * WGM, gsz = (nM - fm) < WGM ? (nM - fm) : WGM;
        u.pm = fm + ((wgid % nig) % gsz); u.pn = (wgid % nig) / gsz; return true;
    }
    __device__ __forceinline__ void a_ready(const Unit&) const {}
    __device__ __forceinline__ void done(const Unit&) const {}
};

__device__ __forceinline__ unsigned cvt_pk_bf16(float lo, float hi) { unsigned r; asm volatile("v_cvt_pk_bf16_f32 %0, %1, %2" : "=v"(r) : "v"(lo), "v"(hi)); return r; }
typedef float f32x2 __attribute__((ext_vector_type(2)));
template <class Epi, class Sched, bool ALIGN_EPI = false, bool SP2 = false>
__device__ __forceinline__ void gemm_phase(PG8_LAS unsigned char* lds, const Gemm g, const Sched& S, const Epi& E) {
    int tid_ = threadIdx.x; asm volatile("" : "+v"(tid_));
    const int tid = tid_, wid = __builtin_amdgcn_readfirstlane(tid >> 6), lane = tid & 63, wr = wid >> 2, wc = wid & 3, fr = lane & 15, fq = lane >> 4;
    const int K = g.K, nt = K / BK;
    unsigned voffA[2], voffB[2];
#pragma unroll
    for (int i = 0; i < 2; ++i) { int R, C; stage_rc(tid * 16 + i * 8192, R, C); const int Rb = Epi::PERM ? ((R & ~31) + perm32(R & 31)) : R;
        voffA[i] = (unsigned)(R * K + C) * 2u; voffB[i] = (unsigned)(Rb * K + C) * 2u; }
    const size_t kstep = (size_t)(BK * 2);
    const size_t hstep = (size_t)HALF * K * 2;
    const size_t tstep = 2 * hstep;
    const unsigned ldsw = (unsigned)wid * 1024u;
    const int aoff = lds_byte(wr * 64 + fr, fq * 8), boff = lds_byte(wc * 32 + fr, fq * 8);
#define PG8_SA(b, h) (((b) * 2 + (h)) * HTB)
#define PG8_SB(b, h) ((4 + (b) * 2 + (h)) * HTB)
#define PG8_STAGE(bufoff, gbase, voff) do { _Pragma("unroll") for (int _i = 0; _i < 2; ++_i) \
        __builtin_amdgcn_global_load_lds((const unsigned*)((const char*)(gbase) + (voff)[_i]), (PG8_LAS unsigned*)(lds + (bufoff) + ldsw + _i * 8192), 16, 0, 0); } while (0)
#define PG8_LDA(dst, b, h) do { _Pragma("unroll") for (int m = 0; m < 4; ++m) _Pragma("unroll") for (int k = 0; k < 2; ++k) dst[m][k] = *(const PG8_LAS bf16x8*)(lds + PG8_SA(b, h) + aoff + m * 2048 + k * 1024); } while (0)
#define PG8_LDB(dst, b, h) do { _Pragma("unroll") for (int n = 0; n < 2; ++n) _Pragma("unroll") for (int k = 0; k < 2; ++k) dst[n][k] = *(const PG8_LAS bf16x8*)(lds + PG8_SB(b, h) + boff + n * 2048 + k * 1024); } while (0)
#define PG8_MMA(ai, bj, At, Bt) do { __builtin_amdgcn_s_setprio(1); _Pragma("unroll") for (int m = 0; m < 4; ++m) _Pragma("unroll") for (int n = 0; n < 2; ++n) _Pragma("unroll") for (int k = 0; k < 2; ++k) \
        acc[ai][bj][m][n] = __builtin_amdgcn_mfma_f32_16x16x32_bf16(Bt[n][k], At[m][k], acc[ai][bj][m][n], 0, 0, 0); __builtin_amdgcn_s_setprio(0); } while (0)
#define PG8_WAIT_V(n) asm volatile("s_waitcnt vmcnt(" #n ")" ::: "memory")
#define PG8_WAIT_L(n) asm volatile("s_waitcnt lgkmcnt(" #n ")" ::: "memory")
#define PG8_BAR __builtin_amdgcn_s_barrier()
#define PG8_SCHED __builtin_amdgcn_sched_barrier(0)
    Unit cur, nxt; int ui = 0;
    if (!S.next(0, cur)) return;
    f32x4 acc[2][2][4][2];
#pragma unroll
    for (int a = 0; a < 2; ++a)
#pragma unroll
        for (int b = 0; b < 2; ++b)
#pragma unroll
            for (int m = 0; m < 4; ++m)
#pragma unroll
                for (int n = 0; n < 2; ++n) acc[a][b][m][n] = (f32x4){0.f, 0.f, 0.f, 0.f};
    bf16x8 At[4][2], B0[2][2], B1[2][2];
    const char* cA = (const char*)g.A + (size_t)cur.pm * tstep; const char* cB = (const char*)g.Bt + (size_t)cur.pn * tstep;
    S.a_ready(cur);
    if constexpr (SP2) {
        PG8_STAGE(PG8_SB(0, 0), cB, voffB); PG8_STAGE(PG8_SB(0, 1), cB + hstep, voffB); PG8_STAGE(PG8_SA(0, 0), cA, voffA); PG8_STAGE(PG8_SA(0, 1), cA + hstep, voffA);
        if (wr == 1) PG8_BAR;
        PG8_WAIT_V(2); PG8_BAR;
        PG8_STAGE(PG8_SB(1, 0), cB + kstep, voffB); PG8_STAGE(PG8_SA(1, 0), cA + kstep, voffA); PG8_STAGE(PG8_SB(1, 1), cB + hstep + kstep, voffB);
        PG8_WAIT_V(6); PG8_BAR;
    } else {
        PG8_STAGE(PG8_SB(0, 0), cB, voffB); PG8_STAGE(PG8_SA(0, 0), cA, voffA); PG8_STAGE(PG8_SB(0, 1), cB + hstep, voffB); PG8_STAGE(PG8_SA(0, 1), cA + hstep, voffA);
        if (wr == 1) PG8_BAR;
        PG8_WAIT_V(4); PG8_BAR;
        PG8_STAGE(PG8_SB(1, 0), cB + kstep, voffB); PG8_STAGE(PG8_SA(1, 0), cA + kstep, voffA); PG8_STAGE(PG8_SB(1, 1), cB + hstep + kstep, voffB);
        PG8_WAIT_V(6); PG8_BAR;
    }
    for (;;) {
        const bool has_next = S.next(ui + 1, nxt);
        const char* nA = has_next ? (const char*)g.A + (size_t)nxt.pm * tstep : cA; const char* nB = has_next ? (const char*)g.Bt + (size_t)nxt.pn * tstep : cB;
        for (int t = 0; t < nt; t += 2) {
            const bool last = (t == nt - 2);
            const char* a1 = cA + (size_t)(t + 1) * kstep;
            const char* a2 = last ? nA : cA + (size_t)(t + 2) * kstep; const char* b2 = last ? nB : cB + (size_t)(t + 2) * kstep;
            const char* a3 = a2 + kstep; const char* b3 = b2 + kstep;
            if (last && has_next) S.a_ready(nxt);
            if constexpr (SP2) {
            PG8_LDB(B0, 0, 0); PG8_LDB(B1, 0, 1); PG8_SCHED; PG8_LDA(At, 0, 0); PG8_STAGE(PG8_SA(1, 1), a1 + hstep, voffA);
            PG8_WAIT_V(8); PG8_WAIT_L(0); PG8_BAR; PG8_MMA(0, 0, At, B0); PG8_MMA(0, 1, At, B1); PG8_BAR; PG8_SCHED;
            PG8_LDA(At, 0, 1); PG8_STAGE(PG8_SB(0, 0), b2, voffB); PG8_STAGE(PG8_SB(0, 1), b2 + hstep, voffB); PG8_STAGE(PG8_SA(0, 0), a2, voffA);
            PG8_WAIT_V(8); PG8_WAIT_L(0); PG8_BAR; PG8_MMA(1, 0, At, B0); PG8_MMA(1, 1, At, B1); PG8_BAR; PG8_SCHED;
            PG8_LDB(B0, 1, 0); PG8_LDB(B1, 1, 1); PG8_SCHED; PG8_LDA(At, 1, 0); PG8_STAGE(PG8_SA(0, 1), a2 + hstep, voffA);
            PG8_WAIT_V(8); PG8_WAIT_L(0); PG8_BAR; PG8_MMA(0, 0, At, B0); PG8_MMA(0, 1, At, B1); PG8_BAR; PG8_SCHED;
            PG8_LDA(At, 1, 1); PG8_STAGE(PG8_SB(1, 0), b3, voffB); PG8_STAGE(PG8_SB(1, 1), b3 + hstep, voffB); PG8_STAGE(PG8_SA(1, 0), a3, voffA);
            PG8_WAIT_V(8); PG8_WAIT_L(0); PG8_BAR; PG8_MMA(1, 0, At, B0); PG8_MMA(1, 1, At, B1); PG8_BAR; PG8_SCHED;
            } else {
            PG8_LDB(B0, 0, 0); PG8_SCHED; PG8_LDA(At, 0, 0); PG8_STAGE(PG8_SA(1, 1), a1 + hstep, voffA);
            PG8_WAIT_L(8); PG8_BAR; PG8_WAIT_L(0); PG8_MMA(0, 0, At, B0); PG8_BAR; PG8_SCHED;
            PG8_LDB(B1, 0, 1); PG8_STAGE(PG8_SB(0, 0), b2, voffB);
            PG8_BAR; PG8_WAIT_L(0); PG8_MMA(0, 1, At, B1); PG8_BAR;
            PG8_LDA(At, 0, 1); PG8_STAGE(PG8_SA(0, 0), a2, voffA);
            PG8_BAR; PG8_WAIT_L(0); PG8_MMA(1, 0, At, B0); PG8_BAR; PG8_SCHED;
            PG8_STAGE(PG8_SB(0, 1), b2 + hstep, voffB);
            PG8_WAIT_V(6); PG8_BAR; PG8_MMA(1, 1, At, B1); PG8_BAR;
            PG8_LDB(B0, 1, 0); PG8_SCHED; PG8_LDA(At, 1, 0); PG8_STAGE(PG8_SA(0, 1), a2 + hstep, voffA);
            PG8_WAIT_L(8); PG8_BAR; PG8_WAIT_L(0); PG8_MMA(0, 0, At, B0); PG8_BAR; PG8_SCHED;
            PG8_LDB(B1, 1, 1); PG8_STAGE(PG8_SB(1, 0), b3, voffB);
            PG8_BAR; PG8_WAIT_L(0); PG8_MMA(0, 1, At, B1); PG8_BAR;
            PG8_LDA(At, 1, 1); PG8_STAGE(PG8_SA(1, 0), a3, voffA);
            PG8_BAR; PG8_WAIT_L(0); PG8_MMA(1, 0, At, B0); PG8_BAR; PG8_SCHED;
            PG8_STAGE(PG8_SB(1, 1), b3 + hstep, voffB);
            PG8_WAIT_V(6); PG8_BAR; PG8_MMA(1, 1, At, B1); PG8_BAR;
            }
        }
        if constexpr (ALIGN_EPI) { if (wr == 0) PG8_BAR; }
        if constexpr (!Epi::AFTER_DRAIN) { E(acc, cur, wr, wc, fr, fq); S.done(cur); }
        if (!has_next) break;
#pragma unroll
        for (int a = 0; a < 2; ++a)
#pragma unroll
            for (int b = 0; b < 2; ++b)
#pragma unroll
                for (int m = 0; m < 4; ++m)
#pragma unroll
                    for (int n = 0; n < 2; ++n) acc[a][b][m][n] = (f32x4){0.f, 0.f, 0.f, 0.f};
        cur = nxt; cA = nA; cB = nB; ++ui;
        if constexpr (ALIGN_EPI) { if (wr == 1) PG8_BAR; }
    }
    PG8_WAIT_V(0);
    if constexpr (!ALIGN_EPI) { if (wr == 0) PG8_BAR; }
    PG8_BAR;
    if constexpr (Epi::AFTER_DRAIN) { E.fused(acc, cur, wr, wc, fr, fq, lds, wid, lane); S.done(cur); }
#undef PG8_SA
#undef PG8_SB
#undef PG8_STAGE
#undef PG8_LDA
#undef PG8_LDB
#undef PG8_MMA
#undef PG8_WAIT_V
#undef PG8_WAIT_L
#undef PG8_BAR
#undef PG8_SCHED
}
}

#ifndef PG8_SP2
#define PG8_SP2 true
#endif
#ifndef PG8_ALIGN
#define PG8_ALIGN true
#endif
#define GAS __attribute__((address_space(1)))
#define LAS __attribute__((address_space(3)))
typedef unsigned short bf16;
typedef unsigned v4u __attribute__((ext_vector_type(4)));
typedef float f32x4 __attribute__((ext_vector_type(4)));
typedef short bf16x8 __attribute__((ext_vector_type(8)));
typedef GAS unsigned gu32;
typedef GAS unsigned long long gu64;
#define RLX_AGENT __ATOMIC_RELAXED, __HIP_MEMORY_SCOPE_AGENT
#define LDS_WAIT() asm volatile("s_waitcnt lgkmcnt(0)" ::: "memory")
#define VM_WAIT() asm volatile("s_waitcnt vmcnt(0)" ::: "memory")
__device__ __forceinline__ unsigned long long rt() { return __builtin_amdgcn_s_memrealtime(); }
__device__ __forceinline__ unsigned f2bf(float f) { unsigned u = __builtin_bit_cast(unsigned, f); return (u + 0x7fffu + ((u >> 16) & 1u)) >> 16; }
__device__ __forceinline__ unsigned pk2(float lo, float hi) { return f2bf(lo) | (f2bf(hi) << 16); }
#define XB_TMO      128
#define XB_XCNT(j)  (256  + 64 * (j))
#define XB_XSUB(j)  (1280 + 64 * (j))
#define XB_XGEN(j)  (2304 + 64 * (j))
#define XB_TOP      3328
#define XB_TOPGEN   3392
#define XCD_BAR_WORDS 3456
#define XB_SPIN_CAP (1u << 18)

__device__ __forceinline__ unsigned xb_ld(unsigned* p)              { return __hip_atomic_load(p, __ATOMIC_RELAXED, __HIP_MEMORY_SCOPE_AGENT); }
__device__ __forceinline__ unsigned xb_add(unsigned* p, unsigned v) { return __hip_atomic_fetch_add(p, v, __ATOMIC_RELAXED, __HIP_MEMORY_SCOPE_AGENT); }
__device__ __forceinline__ unsigned xb_xcc_id() { return (unsigned)__builtin_amdgcn_s_getreg((3 << 11) | 20) & 0xFu; }
#define XB_SPIN(cond, bar) do { unsigned _sp = 0; while (cond) { __builtin_amdgcn_s_sleep(1); \
    if ((++_sp & 255u) == 0u) { if (xb_ld(&(bar)[XB_TMO])) break; if (_sp > XB_SPIN_CAP) { atomicAdd(&(bar)[XB_TMO], 1u); break; } } } } while (0)

struct XcdBarrier {
    unsigned* bar; unsigned x;
    volatile LAS unsigned* st;
};

__device__ __forceinline__ XcdBarrier xcd_barrier_post(unsigned* bar, volatile LAS unsigned* st) {
    XcdBarrier b; b.bar = bar; b.x = xb_xcc_id(); b.st = st;
    if (threadIdx.x == 0) (void)xb_add(&bar[XB_XCNT(b.x)], 1u);
    return b;
}
__device__ __forceinline__ void xcd_barrier_complete(unsigned* bar, unsigned x, unsigned& nloc, unsigned& nx) {
    const unsigned G = gridDim.x * gridDim.y * gridDim.z;
    unsigned sum, cnt, mine, sp = 0u;
    for (;;) {
        sum = 0u; cnt = 0u; mine = 0u;
#pragma unroll
        for (unsigned j = 0; j < 16; ++j) { const unsigned c = xb_ld(&bar[XB_XCNT(j)]); sum += c; cnt += (c > 0u) ? 1u : 0u; mine = (j == x) ? c : mine; }
        if (sum == G) break;
        __builtin_amdgcn_s_sleep(1);
        if ((++sp & 255u) == 0u) { if (xb_ld(&bar[XB_TMO])) break; if (sp > XB_SPIN_CAP) { atomicAdd(&bar[XB_TMO], 1u); break; } }
    }
    nloc = mine > 0u ? mine : 1u; nx = cnt > 0u ? cnt : 1u;
}

__device__ __forceinline__ void xcd_barrier(const XcdBarrier& b) {
    asm volatile("s_waitcnt vmcnt(0)" ::: "memory");
    __syncthreads();
    if (threadIdx.x == 0) {
        unsigned* bar = b.bar;
        __builtin_amdgcn_s_waitcnt(0);
        unsigned nloc = b.st[0], nx = b.st[1];
        if (nloc == 0u) { xcd_barrier_complete(bar, b.x, nloc, nx); b.st[0] = nloc; b.st[1] = nx; }
        const unsigned old = xb_add(&bar[XB_XSUB(b.x)], 1u);
        const unsigned gen = old / nloc;
        if (old + 1u == (gen + 1u) * nloc) {
            __builtin_amdgcn_fence(__ATOMIC_RELEASE, "agent");
            asm volatile("s_waitcnt vmcnt(0)" ::: "memory");
            const unsigned og = xb_add(&bar[XB_TOP], 1u);
            const unsigned tg = og / nx;
            if (og + 1u == (tg + 1u) * nx) xb_add(&bar[XB_TOPGEN], 1u);
            else XB_SPIN(xb_ld(&bar[XB_TOPGEN]) == tg, bar);
            __builtin_amdgcn_fence(__ATOMIC_ACQUIRE, "agent");
            xb_add(&bar[XB_XGEN(b.x)], 1u);
            asm volatile("s_waitcnt vmcnt(0)" ::: "memory");
        } else {
            XB_SPIN(xb_ld(&bar[XB_XGEN(b.x)]) == gen, bar);
            __builtin_amdgcn_fence(__ATOMIC_ACQUIRE, "agent");
            asm volatile("s_waitcnt vmcnt(0)" ::: "memory");
        }
    }
    __syncthreads();
}

constexpr int NWAVES = 8, NT = 512;
constexpr int DM = 2048, SEQ = 4096, NBP = 2, MP = NBP * SEQ, MS = 32, MT = MP + MS, MPAD = MP + 256, DEPTH = 4;
constexpr int DSSD = 1024, DXBC = 1536, NH = 16, HP = 64, DST = 128;
constexpr int NQH = 8, NKV = 2, HD = 64, WIN = 128;
constexpr int DCONV = 512, DFF = 5632;
constexpr int NPROJ = 5120, PP = 4864, PSP = 4880;
constexpr int C_Z = 0, C_X = 1024, C_B = 2048, C_C = 2304, C_Q = 2560, C_K = 3072, C_V = 3200, C_GB = 3328, C_GC = 3840, C_HC = 4352, C_DT = 4864;
constexpr int NMOD = 12288, NMR = 34;
constexpr float EPS = 1e-6f;
constexpr int NCH = 64, CL = 64;

constexpr size_t O_YP = 0;
constexpr size_t O_YS = O_YP + (size_t)MP * DM;
constexpr size_t O_PSSM = O_YS + (size_t)MS * DM;
constexpr size_t O_PSSMCONV = O_PSSM + (size_t)DEPTH * NBP * NH * HP * DST;
constexpr size_t O_PWK = O_PSSMCONV + (size_t)DEPTH * NBP * 3 * DXBC;
constexpr size_t O_PWV = O_PWK + (size_t)DEPTH * NBP * WIN * NKV * HD;
constexpr size_t O_PSC = O_PWV + (size_t)DEPTH * NBP * WIN * NKV * HD;
constexpr size_t O_PFC = O_PSC + (size_t)DEPTH * NBP * 2 * DCONV;
constexpr size_t O_SSSM = O_PFC + (size_t)DEPTH * NBP * 2 * DFF;
constexpr size_t O_SSSMCONV = O_SSSM + (size_t)DEPTH * MS * NH * HP * DST;
constexpr size_t O_SWK = O_SSSMCONV + (size_t)DEPTH * MS * 3 * DXBC;
constexpr size_t O_SWV = O_SWK + (size_t)DEPTH * MS * WIN * NKV * HD;
constexpr size_t O_SSC = O_SWV + (size_t)DEPTH * MS * WIN * NKV * HD;
constexpr size_t O_SFC = O_SSC + (size_t)DEPTH * MS * 2 * DCONV;
constexpr size_t O_END = O_SFC + (size_t)DEPTH * MS * 2 * DFF;
static_assert(O_END == 41422848, "output size");

constexpr size_t MiB = 1u << 20;
constexpr size_t WS_CTL = 0, CTL_ZERO_BYTES = 1 * MiB;
constexpr size_t WS_WIN = 2 * MiB;
constexpr size_t WS_WOUT = 82 * MiB;
constexpr size_t WS_WUP = 114 * MiB;
constexpr size_t WS_WDN = 290 * MiB;
constexpr size_t WS_HA = 378 * MiB;
constexpr size_t WS_PROJ = 411 * MiB;
constexpr size_t WS_DT = 490 * MiB;
constexpr size_t WS_ST = 492 * MiB;
constexpr size_t WS_DECAY = 524 * MiB;
constexpr size_t WS_MIX = 525 * MiB;
constexpr size_t WS_GU = 558 * MiB;
constexpr size_t WS_ACT = 740 * MiB;
constexpr size_t WS_MOD = 829 * MiB;
constexpr size_t WS_ROPE = 836 * MiB;
constexpr size_t WS_END = 838 * MiB;
constexpr int CW_BAR = 4096;

constexpr int RING_OFF = 0, RING_BYTES = 131072;
constexpr int LDSCTL_OFF = RING_BYTES, MISC_OFF = LDSCTL_OFF + 320;
constexpr int LDS_BYTES = 147456;

typedef float f32x16 __attribute__((ext_vector_type(16)));
typedef float f32x2_t __attribute__((ext_vector_type(2)));
typedef __bf16 bf16x2_t __attribute__((ext_vector_type(2)));
typedef short s16x4 __attribute__((ext_vector_type(4)));
typedef short v4i16_t __attribute__((ext_vector_type(4)));
typedef unsigned v2u __attribute__((ext_vector_type(2)));

struct Args { const float* in[30]; float* out; unsigned char* ws; };
constexpr int LARGS_OFF = 131072 + 1024;
struct LA {
    __device__ __forceinline__ unsigned long long ld(int i) const { const unsigned long long v = *(const __attribute__((address_space(3))) unsigned long long*)(unsigned)(LARGS_OFF + 8 * i);
        const unsigned lo = __builtin_amdgcn_readfirstlane((unsigned)v), hi = __builtin_amdgcn_readfirstlane((unsigned)(v >> 32)); return ((unsigned long long)hi << 32) | lo; }
    __device__ __forceinline__ const float* I(int i) const { return (const float*)ld(i); }
    __device__ __forceinline__ float* O() const { return (float*)ld(30); }
    __device__ __forceinline__ unsigned char* W() const { return (unsigned char*)ld(31); }
};

#define DI __device__ __forceinline__
struct PSrow { const bf16* p; const float* d; DI float operator[](int col) const { return col >= C_DT ? d[col - C_DT] : __uint_as_float((unsigned)p[col] << 16); } };
struct GSrow { const bf16* p; DI float operator[](int col) const { return __uint_as_float((unsigned)p[col] << 16); } };
DI unsigned cvtpk(float lo, float hi) { f32x2_t v = {lo, hi}; bf16x2_t b = __builtin_convertvector(v, bf16x2_t); return __builtin_bit_cast(unsigned, b); }
DI float bflo(unsigned u) { return __uint_as_float(u << 16); }
DI float bfhi(unsigned u) { return __uint_as_float(u & 0xffff0000u); }
DI void unpack8(const v4u v, float* f) { f[0] = bflo(v.x); f[1] = bfhi(v.x); f[2] = bflo(v.y); f[3] = bfhi(v.y); f[4] = bflo(v.z); f[5] = bfhi(v.z); f[6] = bflo(v.w); f[7] = bfhi(v.w); }
DI void unpack4(const v2u v, float* f) { f[0] = bflo(v.x); f[1] = bfhi(v.x); f[2] = bflo(v.y); f[3] = bfhi(v.y); }
DI v4u pack8(const float* f) { v4u o; o.x = cvtpk(f[0], f[1]); o.y = cvtpk(f[2], f[3]); o.z = cvtpk(f[4], f[5]); o.w = cvtpk(f[6], f[7]); return o; }
DI float silu_f(float x) { return x * __builtin_amdgcn_rcpf(1.f + __expf(-x)); }
DI float softplus_f(float x) { return x > 20.f ? x : log1pf(__expf(x)); }
DI float wave_sum(float v) {
#pragma unroll
    for (int o = 1; o < 64; o <<= 1) v += __shfl_xor(v, o);
    return v;
}
DI float wave_max(float v) {
#pragma unroll
    for (int o = 1; o < 64; o <<= 1) v = fmaxf(v, __shfl_xor(v, o));
    return v;
}
DI float wave_incl_scan(float v, int lane) {
#pragma unroll
    for (int o = 1; o < 64; o <<= 1) { const float t = __shfl_up(v, o); if (lane >= o) v += t; }
    return v;
}
DI int crow(int reg, int h) { return (reg & 3) + 8 * (reg >> 2) + 4 * h; }
DI s16x4 tr_rd(const LAS unsigned char* p) { return __builtin_bit_cast(s16x4, __builtin_amdgcn_ds_read_tr16_b64_v4i16((LAS v4i16_t*)p)); }
DI bf16x8 tr_pair(const LAS unsigned char* plo, const LAS unsigned char* phi) { const s16x4 lo = tr_rd(plo), hi = tr_rd(phi); return __builtin_shufflevector(lo, hi, 0, 1, 2, 3, 4, 5, 6, 7); }
#define MFMA32(a, b, c) __builtin_amdgcn_mfma_f32_32x32x16_bf16((a), (b), (c), 0, 0, 0)
#define MFMA16(a, b, c) __builtin_amdgcn_mfma_f32_16x16x32_bf16((a), (b), (c), 0, 0, 0)
DI bf16x8 pack_frag(const f32x16& x, int s) {
    v4u p; p.x = cvtpk(x[8 * s + 0], x[8 * s + 1]); p.y = cvtpk(x[8 * s + 2], x[8 * s + 3]); p.z = cvtpk(x[8 * s + 4], x[8 * s + 5]); p.w = cvtpk(x[8 * s + 6], x[8 * s + 7]);
    return __builtin_bit_cast(bf16x8, p);
}
DI f32x16 zero16() { f32x16 z; for (int i = 0; i < 16; ++i) z[i] = 0.f; return z; }

struct TItem { const float* src; bf16* dst; int nsrc, K; bool ok; };
DI TItem p0_item(const LA& A, int it, int lane) {
    constexpr int I_IN = (DM / 64) * (NPROJ / 32), I_OUT = (DM / 64) * (DM / 32), I_UP = (DM / 64) * (2 * DFF / 32), I_DN = (DFF / 64) * (DM / 32);
    constexpr int I_L = I_IN + I_OUT + I_UP + I_DN;
    const int l = it / I_L; int r = it % I_L;
    const float* W; bf16* WT; int K, Nsrc, Ndst; bool winmap = false;
    if (r < I_IN) { W = A.I(14) + (size_t)l * DM * PSP; K = DM; Nsrc = PSP; Ndst = NPROJ; WT = (bf16*)(A.W() + WS_WIN) + (size_t)l * NPROJ * DM; winmap = true; }
    else if (r < I_IN + I_OUT) { r -= I_IN; W = A.I(25) + (size_t)l * DM * DM; K = DM; Nsrc = DM; Ndst = DM; WT = (bf16*)(A.W() + WS_WOUT) + (size_t)l * DM * DM; }
    else if (r < I_IN + I_OUT + I_UP) { r -= I_IN + I_OUT; W = A.I(26) + (size_t)l * DM * 2 * DFF; K = DM; Nsrc = 2 * DFF; Ndst = 2 * DFF; WT = (bf16*)(A.W() + WS_WUP) + (size_t)l * 2 * DFF * DM; }
    else { r -= I_IN + I_OUT + I_UP; W = A.I(29) + (size_t)l * DFF * DM; K = DFF; Nsrc = DM; Ndst = DM; WT = (bf16*)(A.W() + WS_WDN) + (size_t)l * DM * DFF; }
    const int nblk = Ndst / 32, kb = r / nblk, nb = r % nblk, k0 = 64 * kb, n0 = 32 * nb;
    int src = n0 + (lane & 31); bool ok = true;
    if (winmap) { const int n = src; if (n < 2560) src = n; else if (n < 4864) src = n + 16; else if (n < 4880) src = n - 4864 + 2560; else { ok = false; src = 0; } }
    TItem t; t.src = W + (size_t)(k0 + (lane >> 5)) * Nsrc + src; t.dst = WT + (size_t)n0 * K + k0; t.nsrc = Nsrc; t.K = K; t.ok = ok; return t;
}
#define P0_LOAD(v, t) do { _Pragma("unroll") for (int i_ = 0; i_ < 32; ++i_) v[i_] = (t).src[(size_t)(2 * i_) * (t).nsrc]; } while (0)
#define P0_PROC(v, t) do { \
    _Pragma("unroll") for (int i_ = 0; i_ < 32; ++i_) scr[(2 * i_ + (lane >> 5)) * 33 + (lane & 31)] = (t).ok ? v[i_] : 0.f; \
    LDS_WAIT(); asm volatile("" ::: "memory"); \
    _Pragma("unroll") for (int j_ = 0; j_ < 4; ++j_) { const int n_ = (lane >> 3) + 8 * j_; const LAS float* s_ = scr + (8 * (lane & 7)) * 33 + n_; \
        v4u o_; o_.x = cvtpk(s_[0 * 33], s_[1 * 33]); o_.y = cvtpk(s_[2 * 33], s_[3 * 33]); o_.z = cvtpk(s_[4 * 33], s_[5 * 33]); o_.w = cvtpk(s_[6 * 33], s_[7 * 33]); \
        *(GAS v4u*)((t).dst + (size_t)n_ * (t).K + 8 * (lane & 7)) = o_; } \
    LDS_WAIT(); asm volatile("" ::: "memory"); } while (0)
DI void p0_weights(const LA& A, LAS unsigned char* lds, int gw, int NGW, int wave, int lane) {
    LAS float* scr = (LAS float*)(lds + wave * 16384);
    constexpr int NTOT = DEPTH * ((DM / 64) * (NPROJ / 32) + (DM / 64) * (DM / 32) + (DM / 64) * (2 * DFF / 32) + (DFF / 64) * (DM / 32));
    int it = gw; if (it >= NTOT) return;
    TItem t0 = p0_item(A, it, lane), t1 = t0; float v0[32], v1[32];
    P0_LOAD(v0, t0);
    for (;;) {
        const int it1 = it + NGW; const bool h1 = it1 < NTOT;
        if (h1) { t1 = p0_item(A, it1, lane); P0_LOAD(v1, t1); }
        P0_PROC(v0, t0);
        if (!h1) break;
        const int it2 = it1 + NGW; const bool h2 = it2 < NTOT;
        if (h2) { t0 = p0_item(A, it2, lane); P0_LOAD(v0, t0); }
        P0_PROC(v1, t1);
        if (!h2) break;
        it = it2;
    }
}

DI void p0_mod(const LA& A, LAS unsigned char* lds, int bid, int G, int tid, int wave, int lane) {
    LAS float* sw = (LAS float*)lds + wave * (NMR * 64);
    LAS float* red = (LAS float*)lds;
    const float* cp = A.I(8); const float* csm = A.I(9);
    float* mod = (float*)(A.W() + WS_MOD);
    for (int u = bid; u < DEPTH * (NMOD / 128); u += G) {
        const int l = u / (NMOD / 128), nb = u % (NMOD / 128);
        const float* W = A.I(12) + (size_t)l * DM * NMOD + (size_t)(wave * 256) * NMOD + nb * 128 + 2 * lane;
        f32x2_t acc[NMR];
#pragma unroll
        for (int r = 0; r < NMR; ++r) acc[r] = (f32x2_t){0.f, 0.f};
#pragma unroll 1
        for (int ch = 0; ch < 4; ++ch) {
            { const int k = wave * 256 + ch * 64 + lane;
#pragma unroll
              for (int j = 0; j < NMR; ++j) { const float c = j < 2 ? cp[j * DM + k] : csm[(j - 2) * DM + k]; sw[j * 64 + lane] = silu_f(c); } }
            LDS_WAIT(); asm volatile("" ::: "memory");
#pragma unroll 1
            for (int kb = 0; kb < 4; ++kb) {
                f32x2_t w[16];
#pragma unroll
                for (int i = 0; i < 16; ++i) w[i] = *(const GAS f32x2_t*)(W + (size_t)(ch * 64 + kb * 16 + i) * NMOD);
#pragma unroll
                for (int k4 = 0; k4 < 4; ++k4) {
#pragma unroll
                    for (int r = 0; r < NMR; ++r) { const f32x4 sv = *(const LAS f32x4*)(sw + r * 64 + kb * 16 + 4 * k4);
#pragma unroll
                        for (int e = 0; e < 4; ++e) { const float se = sv[e]; acc[r] += (f32x2_t){se, se} * w[4 * k4 + e]; } }
                    __builtin_amdgcn_sched_barrier(0);
                }
            }
            LDS_WAIT(); asm volatile("" ::: "memory");
        }
        __syncthreads();
#pragma unroll
        for (int q = 0; q < 2; ++q) {
#pragma unroll
            for (int rr = 0; rr < 17; ++rr) *(LAS f32x2_t*)(red + (wave * 17 + rr) * 128 + 2 * lane) = acc[17 * q + rr];
            __syncthreads();
            for (int i = tid; i < 17 * 128; i += NT) { const int rr = i >> 7, n = i & 127; float sum = A.I(13)[(size_t)l * NMOD + nb * 128 + n];
#pragma unroll
                for (int w8 = 0; w8 < 8; ++w8) sum += red[(w8 * 17 + rr) * 128 + n];
                mod[((size_t)l * NMR + 17 * q + rr) * NMOD + nb * 128 + n] = sum; }
            __syncthreads();
        }
    }
}

DI void p0_rope(const LA& A, int gt, int NGT) {
    float* tab = (float*)(A.W() + WS_ROPE);
    for (int i = gt; i < 4097 * 32; i += NGT) { const int pi = i >> 5, j = i & 31; const float pos = pi < 4096 ? (float)pi : 16384.f;
        const float inv = powf(10000.f, -(float)j / 32.f); const float ang = pos * inv; float s, c; sincosf(ang, &s, &c); tab[2 * i] = c; tab[2 * i + 1] = s; }
}

DI void phase_norm(const LA& A, int l, int which, int gw, int NGW, int lane) {
    const bool first = (l == 0 && which == 0);
    const float* xp = first ? A.I(0) : A.O() + O_YP;
    const float* xs = first ? A.I(1) : A.O() + O_YS;
    const float* nw = A.I(which ? 11 : 10) + (size_t)l * DM;
    const float* mod = (const float*)(A.W() + WS_MOD) + (size_t)l * NMR * NMOD + (which ? 3 : 0) * DM;
    bf16* hA = (bf16*)(A.W() + WS_HA);
    for (int row = gw; row < MT; row += NGW) {
        const float* xr = row < MP ? xp + (size_t)row * DM : xs + (size_t)(row - MP) * DM;
        const int b = row < MP ? row / SEQ : 2 + row - MP;
        const float* sh = mod + (size_t)b * NMOD; const float* sc = sh + DM;
        f32x4 v[8]; float ss = 0.f;
#pragma unroll
        for (int j = 0; j < 8; ++j) { v[j] = ((const GAS f32x4*)xr)[lane + 64 * j]; ss += (v[j].x * v[j].x + v[j].y * v[j].y) + (v[j].z * v[j].z + v[j].w * v[j].w); }
        const float rstd = 1.f / sqrtf(wave_sum(ss) * (1.f / DM) + EPS);
#pragma unroll
        for (int j = 0; j < 8; ++j) { const f32x4 w = ((const GAS f32x4*)nw)[lane + 64 * j], s = ((const GAS f32x4*)sc)[lane + 64 * j], t = ((const GAS f32x4*)sh)[lane + 64 * j];
            const f32x4 o = v[j] * rstd * w * (1.f + s) + t; v2u pk; pk.x = cvtpk(o.x, o.y); pk.y = cvtpk(o.z, o.w);
            *(GAS v2u*)(hA + (size_t)row * DM + 4 * (lane + 64 * j)) = pk; }
    }
}

namespace pg8 {
struct EpiProj {
    static constexpr bool PERM = true, AFTER_DRAIN = false;
    bf16_t* O; float* DT;
    __device__ __forceinline__ void operator()(const f32x4 (&acc)[2][2][4][2], const Unit& u, int wr, int wc, int fr, int fq) const {
        const int row0 = u.pm * BM + wr * 64 + fr;
        if (u.pn < 19) {
            const int col0 = u.pn * BM + wc * 32 + 8 * fq;
#pragma unroll
            for (int ai = 0; ai < 2; ++ai)
#pragma unroll
                for (int m = 0; m < 4; ++m) { bf16_t* rowp = O + (size_t)(row0 + ai * HALF + m * 16) * PP + col0;
#pragma unroll
                    for (int bj = 0; bj < 2; ++bj) { const f32x4 v0 = acc[ai][bj][m][0], v1 = acc[ai][bj][m][1];
                        u32x4 w; w.x = cvtpk(v0[0], v0[1]); w.y = cvtpk(v0[2], v0[3]); w.z = cvtpk(v1[0], v1[1]); w.w = cvtpk(v1[2], v1[3]);
                        *(u32x4*)(rowp + bj * HALF) = w; } }
        } else if (wc == 0 && fq < 2) {
#pragma unroll
            for (int ai = 0; ai < 2; ++ai)
#pragma unroll
                for (int m = 0; m < 4; ++m) { float* dp = DT + (size_t)(row0 + ai * HALF + m * 16) * 16 + 8 * fq;
                    *(f32x4*)dp = acc[ai][0][m][0]; *(f32x4*)(dp + 4) = acc[ai][0][m][1]; }
        }
    }
};
struct EpiResid {
    static constexpr bool PERM = false, AFTER_DRAIN = false;
    const float* xin; float* xout; const float* gate;
    __device__ __forceinline__ void operator()(const f32x4 (&acc)[2][2][4][2], const Unit& u, int wr, int wc, int fr, int fq) const {
        const int row0 = u.pm * BM + wr * 64 + fr, col0 = u.pn * BM + wc * 32 + 4 * fq;
        const float* gp = gate + (size_t)(u.pm / 16) * NMOD + col0;
        f32x4 gv[2][2];
#pragma unroll
        for (int bj = 0; bj < 2; ++bj)
#pragma unroll
            for (int n = 0; n < 2; ++n) gv[bj][n] = *(const f32x4*)(gp + bj * HALF + n * 16);
#pragma unroll
        for (int ai = 0; ai < 2; ++ai)
#pragma unroll
            for (int m = 0; m < 4; ++m) { const size_t off = (size_t)(row0 + ai * HALF + m * 16) * DM + col0;
#pragma unroll
                for (int bj = 0; bj < 2; ++bj)
#pragma unroll
                    for (int n = 0; n < 2; ++n) { const f32x4 xv = *(const f32x4*)(xin + off + bj * HALF + n * 16); *(f32x4*)(xout + off + bj * HALF + n * 16) = xv + gv[bj][n] * acc[ai][bj][m][n]; }
                asm volatile("" ::: "memory"); }
    }
};
struct EpiPlain {
    static constexpr bool PERM = true, AFTER_DRAIN = false;
    bf16_t* O; int ldc;
    __device__ __forceinline__ void operator()(const f32x4 (&acc)[2][2][4][2], const Unit& u, int wr, int wc, int fr, int fq) const {
        const int row0 = u.pm * BM + wr * 64 + fr, col0 = u.pn * BM + wc * 32 + 8 * fq;
#pragma unroll
        for (int ai = 0; ai < 2; ++ai)
#pragma unroll
            for (int m = 0; m < 4; ++m) { bf16_t* rowp = O + (size_t)(row0 + ai * HALF + m * 16) * ldc + col0;
#pragma unroll
                for (int bj = 0; bj < 2; ++bj) { const f32x4 v0 = acc[ai][bj][m][0], v1 = acc[ai][bj][m][1];
                    u32x4 w; w.x = cvtpk(v0[0], v0[1]); w.y = cvtpk(v0[2], v0[3]); w.z = cvtpk(v1[0], v1[1]); w.w = cvtpk(v1[2], v1[3]);
                    *(u32x4*)(rowp + bj * HALF) = w; } }
    }
};
}

template <class F>
DI void skinny_gemm(LAS unsigned char* lds, const bf16* As, const bf16* Bt, int N, int K, int bid, int G, int tid, int wave, int lane, F epi) {
    asm volatile("" : "+v"(tid), "+v"(lane));
    LAS float* red = (LAS float*)lds;
    const int fr = lane & 15, fq = lane >> 4, kw = K / 8;
    for (int u = bid; u < N / 16; u += G) {
        f32x4 acc0 = {0.f, 0.f, 0.f, 0.f}, acc1 = {0.f, 0.f, 0.f, 0.f};
        const bf16* bp = Bt + (size_t)(u * 16 + fr) * K + wave * kw + 8 * fq;
        const bf16* a0 = As + (size_t)fr * K + wave * kw + 8 * fq; const bf16* a1 = a0 + (size_t)16 * K;
#pragma unroll 4
        for (int k = 0; k < kw; k += 32) { const bf16x8 bv = *(const GAS bf16x8*)(bp + k), x0 = *(const GAS bf16x8*)(a0 + k), x1 = *(const GAS bf16x8*)(a1 + k);
            acc0 = MFMA16(x0, bv, acc0); acc1 = MFMA16(x1, bv, acc1); }
        *(LAS f32x4*)(red + ((wave * 2 + 0) * 64 + lane) * 4) = acc0; *(LAS f32x4*)(red + ((wave * 2 + 1) * 64 + lane) * 4) = acc1;
        __syncthreads();
        { const int col = tid & 15, row = tid >> 4, mt = row >> 4, r16 = row & 15, ln = (r16 >> 2) * 16 + col, i = r16 & 3; float s = 0.f;
#pragma unroll
          for (int w = 0; w < 8; ++w) s += red[((w * 2 + mt) * 64 + ln) * 4 + i];
          epi(row, u * 16 + col, s); }
        __syncthreads();
    }
}

constexpr int XPI = 144, SX_OFF = 8192, SB_OFF = 81920, SC_OFF = 102400, BPI1 = 320, BPI3 = 272, CPI = 272;

template <bool SCALED>
DI void ssd_stage(const LA& A, LAS unsigned char* lds, int l, int b, int c, int g, int tid, int wave, int lane) {
    LAS float* s_dt = (LAS float*)lds; LAS float* s_cs = s_dt + 512;
    constexpr int BPI = SCALED ? BPI1 : BPI3;
    {   const int hh = g * 8 + wave; const int row = b * SEQ + c * CL + lane;
        const float raw = ((const float*)(A.W() + WS_DT))[(size_t)row * 16 + hh] + A.I(17)[l * NH + hh];
        const float dt = softplus_f(raw); const float a = -expf(A.I(18)[l * NH + hh]);
        const float cs = wave_incl_scan(dt * a, lane);
        s_dt[wave * 64 + lane] = dt; s_cs[wave * 64 + lane] = cs; }
    __syncthreads();
    const int cg = tid % 96, seg = tid / 96;
    if (tid < 384 && (!SCALED || cg < 80)) {
        int col;
        if (cg < 64) col = C_X + g * 512 + cg * 8; else if (cg < 80) col = C_B + g * 128 + (cg - 64) * 8; else col = C_C + g * 128 + (cg - 80) * 8;
        const int chx = col - 1024;
        float w[4][8], bias[8];
#pragma unroll
        for (int k = 0; k < 4; ++k) { const f32x4 a0 = *(const GAS f32x4*)(A.I(15) + ((size_t)l * 4 + k) * DXBC + chx), a1 = *(const GAS f32x4*)(A.I(15) + ((size_t)l * 4 + k) * DXBC + chx + 4);
            w[k][0] = a0.x; w[k][1] = a0.y; w[k][2] = a0.z; w[k][3] = a0.w; w[k][4] = a1.x; w[k][5] = a1.y; w[k][6] = a1.z; w[k][7] = a1.w; }
        { const f32x4 a0 = *(const GAS f32x4*)(A.I(16) + (size_t)l * DXBC + chx), a1 = *(const GAS f32x4*)(A.I(16) + (size_t)l * DXBC + chx + 4);
            bias[0] = a0.x; bias[1] = a0.y; bias[2] = a0.z; bias[3] = a0.w; bias[4] = a1.x; bias[5] = a1.y; bias[6] = a1.z; bias[7] = a1.w; }
        const bf16* proj = (const bf16*)(A.W() + WS_PROJ);
        const int t0 = c * CL + seg * 16;
        float win[3][8];
#pragma unroll
        for (int j = 0; j < 3; ++j) { const int t = t0 - 3 + j;
            if (t >= 0) { const v4u v = *(const GAS v4u*)(proj + (size_t)(b * SEQ + t) * PP + col); unpack8(v, win[j]); }
            else {
#pragma unroll
                for (int e = 0; e < 8; ++e) win[j][e] = 0.f; } }
        LAS unsigned char* dst; int pitch; int head = 0;
        if (cg < 64) { head = cg >> 3; dst = lds + SX_OFF + head * 64 * XPI + (cg & 7) * 16; pitch = XPI; }
        else if (cg < 80) { dst = lds + SB_OFF + (cg - 64) * 16; pitch = BPI; }
        else { dst = lds + SC_OFF + (cg - 80) * 16; pitch = CPI; }
        const float cs_end = s_cs[head * 64 + 63];
#pragma unroll
        for (int i = 0; i < 16; ++i) {
            const int ll = seg * 16 + i;
            float cur[8], o[8];
            { const v4u v = *(const GAS v4u*)(proj + (size_t)(b * SEQ + t0 + i) * PP + col); unpack8(v, cur); }
            float scale = 1.f;
            if (SCALED && cg < 64) scale = __expf(cs_end - s_cs[head * 64 + ll]) * s_dt[head * 64 + ll];
#pragma unroll
            for (int e = 0; e < 8; ++e) { const float y = bias[e] + w[0][e] * win[0][e] + w[1][e] * win[1][e] + w[2][e] * win[2][e] + w[3][e] * cur[e]; o[e] = silu_f(y) * scale;
                win[0][e] = win[1][e]; win[1][e] = win[2][e]; win[2][e] = cur[e]; }
            *(LAS v4u*)(dst + ll * pitch) = pack8(o);
        }
    }
    __syncthreads();
}

DI void ssd_chunk_state(const LA& A, LAS unsigned char* lds, int l, int u, int tid, int wave, int lane) {
    const int b = u >> 7, c = (u >> 1) & 63, g = u & 1;
    ssd_stage<true>(A, lds, l, b, c, g, tid, wave, lane);
    const int r = lane & 31, h = lane >> 5, blk = (lane >> 4) & 1, q = (lane & 15) >> 2, p4 = lane & 3;
    const LAS unsigned char* xb = lds + SX_OFF + wave * 64 * XPI + 32 * blk + 8 * p4;
    const LAS unsigned char* bb = lds + SB_OFF + 32 * blk + 8 * p4;
    f32x16 acc[4][2];
#pragma unroll
    for (int nt = 0; nt < 4; ++nt) { acc[nt][0] = zero16(); acc[nt][1] = zero16(); }
#pragma unroll
    for (int ks = 0; ks < 4; ++ks) {
        const int row0 = 16 * ks + 8 * h + q;
        bf16x8 af[4], bf[2];
#pragma unroll
        for (int nt = 0; nt < 4; ++nt) af[nt] = tr_pair(bb + row0 * BPI1 + nt * 64, bb + (row0 + 4) * BPI1 + nt * 64);
#pragma unroll
        for (int pt = 0; pt < 2; ++pt) bf[pt] = tr_pair(xb + row0 * XPI + pt * 64, xb + (row0 + 4) * XPI + pt * 64);
#pragma unroll
        for (int nt = 0; nt < 4; ++nt) { acc[nt][0] = MFMA32(af[nt], bf[0], acc[nt][0]); acc[nt][1] = MFMA32(af[nt], bf[1], acc[nt][1]); }
    }
    const int hh = g * 8 + wave;
    bf16* st = (bf16*)(A.W() + WS_ST) + ((size_t)((b * NCH + c) * NH + hh) * HP) * DST;
#pragma unroll
    for (int nt = 0; nt < 4; ++nt)
#pragma unroll
        for (int pt = 0; pt < 2; ++pt)
#pragma unroll
            for (int gq = 0; gq < 4; ++gq) { v2u pk; pk.x = cvtpk(acc[nt][pt][4 * gq], acc[nt][pt][4 * gq + 1]); pk.y = cvtpk(acc[nt][pt][4 * gq + 2], acc[nt][pt][4 * gq + 3]);
                *(GAS v2u*)(st + (size_t)(32 * pt + r) * DST + 32 * nt + 8 * gq + 4 * h) = pk; }
    if (lane == 0) ((float*)(A.W() + WS_DECAY))[(b * NCH + c) * NH + hh] = __expf(((LAS float*)lds)[512 + wave * 64 + 63]);
    __syncthreads();
}

DI void ssd_scan(const LA& A, int l, int bid, int G, int tid) {
    unsigned* st = (unsigned*)(A.W() + WS_ST); const float* dec = (const float*)(A.W() + WS_DECAY);
    for (int e = bid * NT + tid; e < NBP * NH * HP * (DST / 2); e += G * NT) {
        const int np = e & 63, p = (e >> 6) & 63, hh = (e >> 12) & 15, b = e >> 16;
        size_t idx = ((size_t)(b * NCH) * NH + hh) * (HP * DST / 2) + p * (DST / 2) + np;
        float h0 = 0.f, h1 = 0.f;
#pragma unroll 8
        for (int c = 0; c < NCH; ++c) { const unsigned s = st[idx]; const float d = dec[(b * NCH + c) * NH + hh]; st[idx] = cvtpk(h0, h1);
            h0 = d * h0 + bflo(s); h1 = d * h1 + bfhi(s); idx += (size_t)NH * (HP * DST / 2); }
        f32x2_t o = {h0, h1};
        *(GAS f32x2_t*)(A.O() + O_PSSM + ((size_t)((l * NBP + b) * NH + hh) * HP + p) * DST + 2 * np) = o;
    }
}

DI void ssd_chunk_out(const LA& A, LAS unsigned char* lds, int l, int u, int tid, int wave, int lane) {
    const int b = u >> 7, c = (u >> 1) & 63, g = u & 1;
    ssd_stage<false>(A, lds, l, b, c, g, tid, wave, lane);
    LAS float* s_dt = (LAS float*)lds; LAS float* s_cs = s_dt + 512; LAS float* s_ss = s_dt + 1024;
    const int r = lane & 31, h = lane >> 5, blk = (lane >> 4) & 1, q = (lane & 15) >> 2, p4 = lane & 3;
    const int hh = g * 8 + wave;
    const LAS unsigned char* bimg = lds + SB_OFF; const LAS unsigned char* cimg = lds + SC_OFF;
    const bf16* hs = (const bf16*)(A.W() + WS_ST) + ((size_t)((b * NCH + c) * NH + hh) * HP) * DST;
    f32x16 X0 = zero16(), X1 = zero16(), X2 = zero16(), Y00 = zero16(), Y01 = zero16(), Y10 = zero16(), Y11 = zero16();
#pragma unroll
    for (int ks = 0; ks < 8; ++ks) {
        const int ko = (16 * ks + 8 * h) * 2;
        const bf16x8 bs0 = *(const LAS bf16x8*)(bimg + r * BPI3 + ko), bs1 = *(const LAS bf16x8*)(bimg + (32 + r) * BPI3 + ko);
        const bf16x8 cl0 = *(const LAS bf16x8*)(cimg + r * CPI + ko), cl1 = *(const LAS bf16x8*)(cimg + (32 + r) * CPI + ko);
        const bf16x8 ha0 = *(const GAS bf16x8*)(hs + (size_t)r * DST + 16 * ks + 8 * h), ha1 = *(const GAS bf16x8*)(hs + (size_t)(32 + r) * DST + 16 * ks + 8 * h);
        X0 = MFMA32(bs0, cl0, X0); X1 = MFMA32(bs0, cl1, X1); X2 = MFMA32(bs1, cl1, X2);
        Y00 = MFMA32(ha0, cl0, Y00); Y01 = MFMA32(ha0, cl1, Y01); Y10 = MFMA32(ha1, cl0, Y10); Y11 = MFMA32(ha1, cl1, Y11);
        if (ks & 1) __builtin_amdgcn_sched_barrier(0);
    }
    const float csl0 = s_cs[wave * 64 + r], csl1 = s_cs[wave * 64 + 32 + r];
    { const float e0 = __expf(csl0), e1 = __expf(csl1);
#pragma unroll
      for (int i = 0; i < 16; ++i) { Y00[i] *= e0; Y10[i] *= e0; Y01[i] *= e1; Y11[i] *= e1; } }
#pragma unroll
    for (int gq = 0; gq < 4; ++gq) {
        const f32x4 csa = *(const LAS f32x4*)(s_cs + wave * 64 + 8 * gq + 4 * h), dta = *(const LAS f32x4*)(s_dt + wave * 64 + 8 * gq + 4 * h);
        const f32x4 csb = *(const LAS f32x4*)(s_cs + wave * 64 + 32 + 8 * gq + 4 * h), dtb = *(const LAS f32x4*)(s_dt + wave * 64 + 32 + 8 * gq + 4 * h);
#pragma unroll
        for (int e = 0; e < 4; ++e) { const int i = 4 * gq + e; const int s = 8 * gq + 4 * h + e;
            const float w0 = __expf(fminf(csl0 - csa[e], 0.f)) * dta[e], w1 = __expf(fminf(csl1 - csa[e], 0.f)) * dta[e], w2 = __expf(fminf(csl1 - csb[e], 0.f)) * dtb[e];
            X0[i] = (s <= r) ? X0[i] * w0 : 0.f; X1[i] = X1[i] * w1; X2[i] = (s <= r) ? X2[i] * w2 : 0.f; }
    }
    {   const LAS unsigned char* xb = lds + SX_OFF + wave * 64 * XPI + 32 * blk + 8 * p4;
#pragma unroll
        for (int ks2 = 0; ks2 < 2; ++ks2) {
            const bf16x8 W0 = pack_frag(X0, ks2), W1 = pack_frag(X1, ks2), W2 = pack_frag(X2, ks2);
            const int ra = 16 * ks2 + 4 * h + q, rb = 32 + 16 * ks2 + 4 * h + q;
            const bf16x8 xa0 = tr_pair(xb + ra * XPI, xb + (ra + 8) * XPI), xa1 = tr_pair(xb + ra * XPI + 64, xb + (ra + 8) * XPI + 64);
            const bf16x8 xc0 = tr_pair(xb + rb * XPI, xb + (rb + 8) * XPI), xc1 = tr_pair(xb + rb * XPI + 64, xb + (rb + 8) * XPI + 64);
            Y00 = MFMA32(xa0, W0, Y00); Y10 = MFMA32(xa1, W0, Y10);
            Y01 = MFMA32(xa0, W1, Y01); Y11 = MFMA32(xa1, W1, Y11);
            Y01 = MFMA32(xc0, W2, Y01); Y11 = MFMA32(xc1, W2, Y11);
        }
    }
    const float Dk = A.I(19)[l * NH + hh];
    const bf16* proj = (const bf16*)(A.W() + WS_PROJ);
    const LAS unsigned char* xrow = lds + SX_OFF + wave * 64 * XPI;
    float ss0 = 0.f, ss1 = 0.f;
#define SSD_EPI1(Y, pt, lt, ssv) do { const size_t zoff = (size_t)(b * SEQ + c * CL + 32 * (lt) + r) * PP + C_Z + hh * 64; \
        _Pragma("unroll") for (int gq = 0; gq < 4; ++gq) { const int p0 = 32 * (pt) + 8 * gq + 4 * h; \
            float xv[4], zv[4]; unpack4(*(const LAS v2u*)(xrow + (32 * (lt) + r) * XPI + p0 * 2), xv); unpack4(*(const GAS v2u*)(proj + zoff + p0), zv); \
            _Pragma("unroll") for (int e = 0; e < 4; ++e) { const float y = (Y[4 * gq + e] + Dk * xv[e]) * silu_f(zv[e]); Y[4 * gq + e] = y; ssv += y * y; } } } while (0)
    SSD_EPI1(Y00, 0, 0, ss0); SSD_EPI1(Y10, 1, 0, ss0); SSD_EPI1(Y01, 0, 1, ss1); SSD_EPI1(Y11, 1, 1, ss1);
#undef SSD_EPI1
    ss0 += __shfl_xor(ss0, 32); ss1 += __shfl_xor(ss1, 32);
    if (h == 0) { s_ss[wave * 64 + r] = ss0; s_ss[wave * 64 + 32 + r] = ss1; }
    __syncthreads();
    float t0 = 0.f, t1 = 0.f;
#pragma unroll
    for (int w = 0; w < 8; ++w) { t0 += s_ss[w * 64 + r]; t1 += s_ss[w * 64 + 32 + r]; }
    const float rs0 = 1.f / sqrtf(t0 * (1.f / 512.f) + EPS), rs1 = 1.f / sqrtf(t1 * (1.f / 512.f) + EPS);
    const float* nw = A.I(20) + (size_t)l * DSSD + hh * 64;
    bf16* mix = (bf16*)(A.W() + WS_MIX);
#define SSD_EPI2(Y, pt, lt, rs) do { bf16* op = mix + (size_t)(b * SEQ + c * CL + 32 * (lt) + r) * DM + hh * 64; \
        _Pragma("unroll") for (int gq = 0; gq < 4; ++gq) { const int p0 = 32 * (pt) + 8 * gq + 4 * h; const f32x4 wv = *(const GAS f32x4*)(nw + p0); \
            v2u pk; pk.x = cvtpk(Y[4 * gq] * rs * wv.x, Y[4 * gq + 1] * rs * wv.y); pk.y = cvtpk(Y[4 * gq + 2] * rs * wv.z, Y[4 * gq + 3] * rs * wv.w); *(GAS v2u*)(op + p0) = pk; } } while (0)
    SSD_EPI2(Y00, 0, 0, rs0); SSD_EPI2(Y10, 1, 0, rs0); SSD_EPI2(Y01, 0, 1, rs1); SSD_EPI2(Y11, 1, 1, rs1);
#undef SSD_EPI2
    __syncthreads();
}

constexpr int KPI = 144, VPI = 192, AK_OFF = 0, AV_OFF = 36864;
DI void attn_unit(const LA& A, LAS unsigned char* lds, int l, int u, int tid, int wave, int lane) {
    const int b = u >> 6, blk = (u >> 1) & 31, kvh = u & 1;
    const bf16* proj = (const bf16*)(A.W() + WS_PROJ);
    const float* rope = (const float*)(A.W() + WS_ROPE);
    {
        const int sub = tid & 7; const float* knw = A.I(22) + (size_t)l * HD;
        const f32x4 wlo = *(const GAS f32x4*)(knw + 4 * sub), whi = *(const GAS f32x4*)(knw + 32 + 4 * sub);
#pragma unroll
        for (int it = 0; it < 4; ++it) { const int j = it * 64 + (tid >> 3); const int t = (blk - 1) * 128 + j;
            float lo[4] = {0.f, 0.f, 0.f, 0.f}, hi[4] = {0.f, 0.f, 0.f, 0.f}; f32x4 cs0 = {1.f, 0.f, 1.f, 0.f}, cs1 = cs0;
            if (t >= 0) { const bf16* kp = proj + (size_t)(b * SEQ + t) * PP + C_K + kvh * 64 + 4 * sub; unpack4(*(const GAS v2u*)kp, lo); unpack4(*(const GAS v2u*)(kp + 32), hi);
                cs0 = *(const GAS f32x4*)(rope + ((size_t)t * 32 + 4 * sub) * 2); cs1 = *(const GAS f32x4*)(rope + ((size_t)t * 32 + 4 * sub) * 2 + 4); }
            float ss = (lo[0] * lo[0] + lo[1] * lo[1]) + (lo[2] * lo[2] + lo[3] * lo[3]) + (hi[0] * hi[0] + hi[1] * hi[1]) + (hi[2] * hi[2] + hi[3] * hi[3]);
            ss += __shfl_xor(ss, 1); ss += __shfl_xor(ss, 2); ss += __shfl_xor(ss, 4);
            const float rstd = 1.f / sqrtf(ss * (1.f / 64.f) + EPS);
            const float cc[4] = {cs0.x, cs0.z, cs1.x, cs1.z}, sn[4] = {cs0.y, cs0.w, cs1.y, cs1.w}; const float wl[4] = {wlo.x, wlo.y, wlo.z, wlo.w}, wh[4] = {whi.x, whi.y, whi.z, whi.w};
            float ol[4], oh[4];
#pragma unroll
            for (int e = 0; e < 4; ++e) { const float a = lo[e] * rstd * wl[e], bb = hi[e] * rstd * wh[e]; ol[e] = a * cc[e] - bb * sn[e]; oh[e] = bb * cc[e] + a * sn[e]; }
            v2u pl, ph; pl.x = cvtpk(ol[0], ol[1]); pl.y = cvtpk(ol[2], ol[3]); ph.x = cvtpk(oh[0], oh[1]); ph.y = cvtpk(oh[2], oh[3]);
            *(LAS v2u*)(lds + AK_OFF + j * KPI + 8 * sub) = pl; *(LAS v2u*)(lds + AK_OFF + j * KPI + 64 + 8 * sub) = ph;
            if (blk == 31 && j >= 128) { float* o = A.O() + O_PWK + ((size_t)((l * NBP + b) * WIN + (j - 128)) * NKV + kvh) * HD;
                f32x4 v0 = {ol[0], ol[1], ol[2], ol[3]}, v1 = {oh[0], oh[1], oh[2], oh[3]}; *(GAS f32x4*)(o + 4 * sub) = v0; *(GAS f32x4*)(o + 32 + 4 * sub) = v1; }
        }
#pragma unroll
        for (int it = 0; it < 4; ++it) { const int idx = tid + NT * it; const int j = idx >> 3, ch = idx & 7; const int t = (blk - 1) * 128 + j;
            v4u v = {0u, 0u, 0u, 0u};
            if (t >= 0) v = *(const GAS v4u*)(proj + (size_t)(b * SEQ + t) * PP + C_V + kvh * 64 + 8 * ch);
            *(LAS v4u*)(lds + AV_OFF + j * VPI + 16 * ch) = v;
            if (blk == 31 && j >= 128) { float f[8]; unpack8(v, f); float* o = A.O() + O_PWV + ((size_t)((l * NBP + b) * WIN + (j - 128)) * NKV + kvh) * HD + 8 * ch;
                f32x4 v0 = {f[0], f[1], f[2], f[3]}, v1 = {f[4], f[5], f[6], f[7]}; *(GAS f32x4*)o = v0; *(GAS f32x4*)(o + 4) = v1; }
        }
    }
    __syncthreads();
    const int r = lane & 31, h = lane >> 5, blkl = (lane >> 4) & 1, q = (lane & 15) >> 2, p4 = lane & 3;
    const int qh = wave >> 1, half = wave & 1, head = kvh * 4 + qh;
    const float sink = A.I(23)[l * NQH + head];
    const float* qnw = A.I(21) + (size_t)l * HD;
    bf16* mix = (bf16*)(A.W() + WS_MIX);
#pragma unroll 1
    for (int tt = 0; tt < 2; ++tt) {
        const int tq = 2 * half + tt; const int tok = blk * 128 + 32 * tq + r; const size_t row = (size_t)b * SEQ + tok;
        float qf[4][8]; float ss = 0.f;
#pragma unroll
        for (int ks = 0; ks < 4; ++ks) { unpack8(*(const GAS v4u*)(proj + row * PP + C_Q + head * 64 + 16 * ks + 8 * h), qf[ks]);
#pragma unroll
            for (int e = 0; e < 8; ++e) ss += qf[ks][e] * qf[ks][e]; }
        ss += __shfl_xor(ss, 32);
        const float rstd = 0.125f / sqrtf(ss * (1.f / 64.f) + EPS);
        bf16x8 qb[4];
        {   float o[4][8];
#pragma unroll
            for (int ks = 0; ks < 2; ++ks) {
#pragma unroll
                for (int e = 0; e < 8; ++e) { const int d = 16 * ks + 8 * h + e; const f32x2_t cs = *(const GAS f32x2_t*)(rope + ((size_t)tok * 32 + d) * 2);
                    const float a = qf[ks][e] * rstd * qnw[d], bb = qf[ks + 2][e] * rstd * qnw[d + 32]; o[ks][e] = a * cs.x - bb * cs.y; o[ks + 2][e] = bb * cs.x + a * cs.y; } }
#pragma unroll
            for (int ks = 0; ks < 4; ++ks) qb[ks] = __builtin_bit_cast(bf16x8, pack8(o[ks]));
        }
        f32x16 S[5];
#pragma unroll
        for (int jj = 0; jj < 5; ++jj) { S[jj] = zero16();
#pragma unroll
            for (int ks = 0; ks < 4; ++ks) { const bf16x8 ka = *(const LAS bf16x8*)(lds + AK_OFF + (32 * (tq + jj) + r) * KPI + (16 * ks + 8 * h) * 2); S[jj] = MFMA32(ka, qb[ks], S[jj]); }
            __builtin_amdgcn_sched_barrier(0); }
        float m = sink;
#pragma unroll
        for (int jj = 0; jj < 5; ++jj)
#pragma unroll
            for (int i = 0; i < 16; ++i) { const int dj = 32 * jj + crow(i, h) - r; const bool ok = dj >= 0 && dj <= WIN && (blk > 0 || 32 * (tq + jj) >= 128);
                S[jj][i] = ok ? S[jj][i] : -1e30f; m = fmaxf(m, S[jj][i]); }
        m = fmaxf(m, __shfl_xor(m, 32));
        float sum = 0.f;
#pragma unroll
        for (int jj = 0; jj < 5; ++jj)
#pragma unroll
            for (int i = 0; i < 16; ++i) { const float p = __expf(S[jj][i] - m); S[jj][i] = p; sum += p; }
        sum += __shfl_xor(sum, 32);
        const float inv = 1.f / (sum + __expf(sink - m));
        __builtin_amdgcn_sched_barrier(0);
        f32x16 O0 = zero16(), O1 = zero16();
        const LAS unsigned char* vb = lds + AV_OFF + 32 * blkl + 8 * p4;
#pragma unroll
        for (int jj = 0; jj < 5; ++jj)
#pragma unroll
            for (int ks2 = 0; ks2 < 2; ++ks2) { const bf16x8 pb = pack_frag(S[jj], ks2); const int jr = 32 * (tq + jj) + 16 * ks2 + 4 * h + q;
                const bf16x8 va0 = tr_pair(vb + jr * VPI, vb + (jr + 8) * VPI), va1 = tr_pair(vb + jr * VPI + 64, vb + (jr + 8) * VPI + 64);
                O0 = MFMA32(va0, pb, O0); O1 = MFMA32(va1, pb, O1); __builtin_amdgcn_sched_barrier(0); }
        bf16* op = mix + row * DM + DSSD + head * 64;
#pragma unroll
        for (int gq = 0; gq < 4; ++gq) { v2u pk; pk.x = cvtpk(O0[4 * gq] * inv, O0[4 * gq + 1] * inv); pk.y = cvtpk(O0[4 * gq + 2] * inv, O0[4 * gq + 3] * inv); *(GAS v2u*)(op + 8 * gq + 4 * h) = pk;
            pk.x = cvtpk(O1[4 * gq] * inv, O1[4 * gq + 1] * inv); pk.y = cvtpk(O1[4 * gq + 2] * inv, O1[4 * gq + 3] * inv); *(GAS v2u*)(op + 32 + 8 * gq + 4 * h) = pk; }
    }
    __syncthreads();
}

DI void samp_ssd_unit(const LA& A, LAS unsigned char* lds, int l, int u, int tid, int wave, int lane) {
    const int sb = u >> 1, g = u & 1;
    LAS float* xs = (LAS float*)lds; LAS float* Bv = xs + 512; LAS float* Cv = Bv + 128; LAS float* s_ss = Cv + 128;
    const PSrow ps{(const bf16*)(A.W() + WS_PROJ) + (size_t)(MP + sb) * PP, (const float*)(A.W() + WS_DT) + (size_t)(MP + sb) * 16};
    for (int ci = tid; ci < 768; ci += NT) {
        const int chx = ci < 512 ? g * 512 + ci : (ci < 640 ? 1024 + g * 128 + (ci - 512) : 1280 + g * 128 + (ci - 640));
        const float nr = ps[1024 + chx];
        const float* sp = A.I(3) + ((size_t)(l * MS + sb) * 3) * DXBC + chx;
        const float p0 = sp[0], p1 = sp[DXBC], p2 = sp[2 * DXBC];
        const float* cw = A.I(15) + (size_t)l * 4 * DXBC + chx;
        const float v = silu_f(A.I(16)[(size_t)l * DXBC + chx] + cw[0] * p0 + cw[DXBC] * p1 + cw[2 * DXBC] * p2 + cw[3 * DXBC] * nr);
        float* so = A.O() + O_SSSMCONV + ((size_t)(l * MS + sb) * 3) * DXBC + chx;
        so[0] = p1; so[DXBC] = p2; so[2 * DXBC] = nr;
        xs[ci] = v;
    }
    __syncthreads();
    const int hh = g * 8 + wave;
    const float dt = softplus_f(ps[C_DT + hh] + A.I(17)[l * NH + hh]);
    const float dA = expf(dt * -expf(A.I(18)[l * NH + hh]));
    const float Dk = A.I(19)[l * NH + hh];
    const size_t hoff = ((size_t)((l * MS + sb) * NH + hh) * HP) * DST;
    const float* h0 = A.I(2) + hoff; float* ho = A.O() + O_SSSM + hoff;
    const float b0 = Bv[2 * lane], b1 = Bv[2 * lane + 1], c0 = Cv[2 * lane], c1 = Cv[2 * lane + 1];
    float ymine = 0.f;
#pragma unroll 4
    for (int p = 0; p < HP; ++p) { const float xp = xs[wave * 64 + p]; const f32x2_t hv = *(const GAS f32x2_t*)(h0 + p * DST + 2 * lane);
        f32x2_t hn; hn.x = dA * hv.x + dt * xp * b0; hn.y = dA * hv.y + dt * xp * b1; *(GAS f32x2_t*)(ho + p * DST + 2 * lane) = hn;
        const float part = wave_sum(c0 * hn.x + c1 * hn.y); if (lane == p) ymine = part + Dk * xp; }
    const float y = ymine * silu_f(ps[C_Z + hh * 64 + lane]);
    const float ssq = wave_sum(y * y);
    if (lane == 0) s_ss[wave] = ssq;
    __syncthreads();
    float tot = 0.f;
#pragma unroll
    for (int w = 0; w < 8; ++w) tot += s_ss[w];
    const float rstd = 1.f / sqrtf(tot * (1.f / 512.f) + EPS);
    const float o = y * rstd * A.I(20)[(size_t)l * DSSD + hh * 64 + lane];
    ((bf16*)(A.W() + WS_MIX))[(size_t)(MP + sb) * DM + hh * 64 + lane] = (bf16)(cvtpk(o, 0.f) & 0xffffu);
    __syncthreads();
}

DI void samp_attn_unit(const LA& A, LAS unsigned char* lds, int l, int u, int tid, int wave, int lane) {
    const int sb = u >> 1, kvh = u & 1;
    LAS float* s_q = (LAS float*)lds;
    LAS float* s_k = s_q + 256;
    LAS float* s_v = s_k + 64;
    LAS float* s_p = s_v + 64;
    const PSrow ps{(const bf16*)(A.W() + WS_PROJ) + (size_t)(MP + sb) * PP, (const float*)(A.W() + WS_DT) + (size_t)(MP + sb) * 16};
    const float* rope = (const float*)(A.W() + WS_ROPE) + (size_t)4096 * 64;
    if (wave < 5) {
        const int col = wave < 4 ? C_Q + (kvh * 4 + wave) * 64 : C_K + kvh * 64;
        const float x = ps[col + lane];
        const float rstd = 1.f / sqrtf(wave_sum(x * x) * (1.f / 64.f) + EPS);
        const float w = (wave < 4 ? A.I(21) : A.I(22))[(size_t)l * HD + lane];
        const float xn = x * rstd * w; const float other = __shfl_xor(xn, 32);
        const int i = lane & 31; const float cs = rope[2 * i], sn = rope[2 * i + 1];
        const float o = lane < 32 ? xn * cs - other * sn : xn * cs + other * sn;
        if (wave < 4) s_q[wave * 64 + lane] = o * 0.125f; else s_k[lane] = o;
    } else if (wave == 5) s_v[lane] = ps[C_V + kvh * 64 + lane];
    __syncthreads();
    const float* kc = A.I(4) + ((size_t)(l * MS + sb) * WIN) * (NKV * HD) + kvh * HD;
    const float* vc = A.I(5) + ((size_t)(l * MS + sb) * WIN) * (NKV * HD) + kvh * HD;
    if (wave < 4) {
        const int head = kvh * 4 + wave; const float sink = A.I(23)[l * NQH + head];
        float s0 = 0.f, s1 = 0.f, s2 = 0.f;
        const float* k0 = kc + (size_t)lane * (NKV * HD); const float* k1 = kc + (size_t)(lane + 64) * (NKV * HD);
#pragma unroll
        for (int d4 = 0; d4 < 16; ++d4) { const f32x4 qv = *(const LAS f32x4*)(s_q + wave * 64 + 4 * d4); const f32x4 a = *(const GAS f32x4*)(k0 + 4 * d4), bq = *(const GAS f32x4*)(k1 + 4 * d4); const f32x4 kn = *(const LAS f32x4*)(s_k + 4 * d4);
            s0 += (qv.x * a.x + qv.y * a.y) + (qv.z * a.z + qv.w * a.w); s1 += (qv.x * bq.x + qv.y * bq.y) + (qv.z * bq.z + qv.w * bq.w); s2 += (qv.x * kn.x + qv.y * kn.y) + (qv.z * kn.z + qv.w * kn.w); }
        float m = fmaxf(fmaxf(s0, s1), fmaxf(s2, sink)); m = wave_max(m);
        const float p0 = __expf(s0 - m), p1 = __expf(s1 - m), p2 = __expf(s2 - m);
        const float den = wave_sum(p0 + p1) + p2 + __expf(sink - m);
        const float inv = 1.f / den;
        s_p[wave * 132 + lane] = p0 * inv; s_p[wave * 132 + 64 + lane] = p1 * inv; if (lane == 0) s_p[wave * 132 + 128] = p2 * inv;
        LDS_WAIT(); asm volatile("" ::: "memory");
        float o = s_p[wave * 132 + 128] * s_v[lane];
#pragma unroll 8
        for (int j = 0; j < WIN; ++j) o += s_p[wave * 132 + j] * vc[(size_t)j * (NKV * HD) + lane];
        ((bf16*)(A.W() + WS_MIX))[(size_t)(MP + sb) * DM + DSSD + head * 64 + lane] = (bf16)(cvtpk(o, 0.f) & 0xffffu);
    } else {
        float* ok = A.O() + O_SWK + ((size_t)(l * MS + sb) * WIN) * (NKV * HD) + kvh * HD;
        float* ov = A.O() + O_SWV + ((size_t)(l * MS + sb) * WIN) * (NKV * HD) + kvh * HD;
        for (int j = wave - 4; j < WIN; j += 4) {
            const float kv = j < WIN - 1 ? kc[(size_t)(j + 1) * (NKV * HD) + lane] : s_k[lane];
            const float vv = j < WIN - 1 ? vc[(size_t)(j + 1) * (NKV * HD) + lane] : s_v[lane];
            ok[(size_t)j * (NKV * HD) + lane] = kv; ov[(size_t)j * (NKV * HD) + lane] = vv; }
    }
    __syncthreads();
}

DI void samp_sconv_unit(const LA& A, int l, int u, int tid) {
    for (int i = tid; i < 4 * DCONV; i += NT) { const int sb = u * 4 + (i >> 9), ch = i & 511;
        const PSrow ps{(const bf16*)(A.W() + WS_PROJ) + (size_t)(MP + sb) * PP, (const float*)(A.W() + WS_DT) + (size_t)(MP + sb) * 16};
        const float vn = ps[C_GC + ch] * ps[C_HC + ch];
        const float* sp = A.I(6) + ((size_t)(l * MS + sb) * 2) * DCONV + ch; const float p0 = sp[0], p1 = sp[DCONV];
        const float* cw = A.I(24) + (size_t)l * 3 * DCONV + ch;
        const float y = ps[C_GB + ch] * (cw[0] * p0 + cw[DCONV] * p1 + cw[2 * DCONV] * vn);
        ((bf16*)(A.W() + WS_MIX))[(size_t)(MP + sb) * DM + 1536 + ch] = (bf16)(cvtpk(y, 0.f) & 0xffffu);
        float* so = A.O() + O_SSC + ((size_t)(l * MS + sb) * 2) * DCONV + ch; so[0] = p1; so[DCONV] = vn; }
}

DI void sconv_unit(const LA& A, int l, int u, int tid) {
    const int b = u >> 6, tile = u & 63, cg = tid & 63, seg = tid >> 6;
    const bf16* proj = (const bf16*)(A.W() + WS_PROJ); bf16* mix = (bf16*)(A.W() + WS_MIX);
    const int t0 = tile * 64 + seg * 8, ch = cg * 8;
    float w[3][8];
#pragma unroll
    for (int k = 0; k < 3; ++k) { const f32x4 a0 = *(const GAS f32x4*)(A.I(24) + ((size_t)l * 3 + k) * DCONV + ch), a1 = *(const GAS f32x4*)(A.I(24) + ((size_t)l * 3 + k) * DCONV + ch + 4);
        w[k][0] = a0.x; w[k][1] = a0.y; w[k][2] = a0.z; w[k][3] = a0.w; w[k][4] = a1.x; w[k][5] = a1.y; w[k][6] = a1.z; w[k][7] = a1.w; }
    float win[2][8];
#pragma unroll
    for (int j = 0; j < 2; ++j) { const int t = t0 - 2 + j;
        if (t >= 0) { float gc[8], hc[8]; const bf16* rp = proj + (size_t)(b * SEQ + t) * PP; unpack8(*(const GAS v4u*)(rp + C_GC + ch), gc); unpack8(*(const GAS v4u*)(rp + C_HC + ch), hc);
#pragma unroll
            for (int e = 0; e < 8; ++e) win[j][e] = gc[e] * hc[e]; }
        else {
#pragma unroll
            for (int e = 0; e < 8; ++e) win[j][e] = 0.f; } }
#pragma unroll
    for (int i = 0; i < 8; ++i) { const int t = t0 + i; const bf16* rp = proj + (size_t)(b * SEQ + t) * PP;
        float gc[8], hc[8], gb[8], o[8]; unpack8(*(const GAS v4u*)(rp + C_GC + ch), gc); unpack8(*(const GAS v4u*)(rp + C_HC + ch), hc); unpack8(*(const GAS v4u*)(rp + C_GB + ch), gb);
#pragma unroll
        for (int e = 0; e < 8; ++e) { const float v = gc[e] * hc[e]; o[e] = gb[e] * (w[0][e] * win[0][e] + w[1][e] * win[1][e] + w[2][e] * v); win[0][e] = win[1][e]; win[1][e] = v; }
        *(GAS v4u*)(mix + (size_t)(b * SEQ + t) * DM + 1536 + ch) = pack8(o); }
    if (tile == 63 && seg == 7) { float* so = A.O() + O_PSC + ((size_t)(l * NBP + b) * 2) * DCONV + ch;
#pragma unroll
        for (int e = 0; e < 8; ++e) { so[e] = win[0][e]; so[DCONV + e] = win[1][e]; } }
    if (tile == 63) { float* so = A.O() + O_PSSMCONV + ((size_t)(l * NBP + b) * 3) * DXBC;
        for (int i = tid; i < 3 * DXBC; i += NT) { const int rr = i / DXBC, cx = i % DXBC; const unsigned short v = proj[(size_t)(b * SEQ + SEQ - 3 + rr) * PP + 1024 + cx]; so[i] = __uint_as_float((unsigned)v << 16); } }
}

DI void act_unit(const LA& A, int l, int u, int tid) {
    const int cb = u % 11, tile = (u / 11) & 63, b = u / (11 * 64), cg = tid & 63, seg = tid >> 6;
    const bf16* gu = (const bf16*)(A.W() + WS_GU); bf16* act = (bf16*)(A.W() + WS_ACT);
    const int t0 = tile * 64 + seg * 8, ch = cb * 512 + cg * 8;
    float w[3][8], bias[8];
#pragma unroll
    for (int k = 0; k < 3; ++k) { const f32x4 a0 = *(const GAS f32x4*)(A.I(27) + ((size_t)l * 3 + k) * DFF + ch), a1 = *(const GAS f32x4*)(A.I(27) + ((size_t)l * 3 + k) * DFF + ch + 4);
        w[k][0] = a0.x; w[k][1] = a0.y; w[k][2] = a0.z; w[k][3] = a0.w; w[k][4] = a1.x; w[k][5] = a1.y; w[k][6] = a1.z; w[k][7] = a1.w; }
    { const f32x4 a0 = *(const GAS f32x4*)(A.I(28) + (size_t)l * DFF + ch), a1 = *(const GAS f32x4*)(A.I(28) + (size_t)l * DFF + ch + 4);
        bias[0] = a0.x; bias[1] = a0.y; bias[2] = a0.z; bias[3] = a0.w; bias[4] = a1.x; bias[5] = a1.y; bias[6] = a1.z; bias[7] = a1.w; }
    float win[2][8];
#pragma unroll
    for (int j = 0; j < 2; ++j) { const int t = t0 - 2 + j;
        if (t >= 0) unpack8(*(const GAS v4u*)(gu + (size_t)(b * SEQ + t) * (2 * DFF) + ch), win[j]);
        else {
#pragma unroll
            for (int e = 0; e < 8; ++e) win[j][e] = 0.f; } }
#pragma unroll
    for (int i = 0; i < 8; ++i) { const int t = t0 + i; const bf16* rp = gu + (size_t)(b * SEQ + t) * (2 * DFF) + ch;
        float gt[8], uu[8], o[8]; unpack8(*(const GAS v4u*)rp, gt); unpack8(*(const GAS v4u*)(rp + DFF), uu);
#pragma unroll
        for (int e = 0; e < 8; ++e) { o[e] = silu_f(bias[e] + w[0][e] * win[0][e] + w[1][e] * win[1][e] + w[2][e] * gt[e]) * uu[e]; win[0][e] = win[1][e]; win[1][e] = gt[e]; }
        *(GAS v4u*)(act + (size_t)(b * SEQ + t) * DFF + ch) = pack8(o); }
    if (tile == 63 && seg == 7) { float* so = A.O() + O_PFC + ((size_t)(l * NBP + b) * 2) * DFF + ch;
#pragma unroll
        for (int e = 0; e < 8; ++e) { so[e] = win[0][e]; so[DFF + e] = win[1][e]; } }
}
DI void samp_act_unit(const LA& A, int l, int sb, int tid) {
    const GSrow gs{(const bf16*)(A.W() + WS_GU) + (size_t)(MP + sb) * (2 * DFF)};
    for (int j = tid; j < DFF; j += NT) { const float gn = gs[j], un = gs[DFF + j];
        const float* sp = A.I(7) + ((size_t)(l * MS + sb) * 2) * DFF + j; const float p0 = sp[0], p1 = sp[DFF];
        const float* cw = A.I(27) + (size_t)l * 3 * DFF + j;
        const float o = silu_f(A.I(28)[(size_t)l * DFF + j] + cw[0] * p0 + cw[DFF] * p1 + cw[2 * DFF] * gn) * un;
        ((bf16*)(A.W() + WS_ACT))[(size_t)(MP + sb) * DFF + j] = (bf16)(cvtpk(o, 0.f) & 0xffffu);
        float* so = A.O() + O_SFC + ((size_t)(l * MS + sb) * 2) * DFF + j; so[0] = p1; so[DFF] = gn; }
}

#ifndef PHMASK
#define PHMASK 0xffffffffu
#endif
#define EN(k) ((((unsigned)(PHMASK)) >> (k)) & 1u)
#ifndef REP_PRO
#define REP_PRO 1
#endif
#ifndef REP_SEL
#define REP_SEL 7
#endif
#ifndef REP_G1
#define REP_G1 1
#endif
#ifndef REP_MIX
#define REP_MIX 1
#endif
#ifndef REP_NA
#define REP_NA 1
#endif
#ifndef REP_P3
#define REP_P3 1
#endif
#ifndef REP_P5
#define REP_P5 1
#endif
__global__ void __launch_bounds__(NT, 2) hymba_fwd(Args KA) {
    extern __shared__ __attribute__((aligned(16))) unsigned char lds_raw[];
    LAS unsigned char* lds = (LAS unsigned char*)lds_raw;
    const int G = gridDim.x, bid = blockIdx.x, NGW = G * NWAVES;
#define IDS() int tid_ = threadIdx.x; asm volatile("" : "+v"(tid_)); const int tid = tid_, lane = tid & 63, wave = __builtin_amdgcn_readfirstlane(tid >> 6), gw = bid * NWAVES + wave; (void)lane; (void)gw
    volatile LAS unsigned* MISC = (volatile LAS unsigned*)(lds + MISC_OFF);
    for (int u = threadIdx.x; u < (LDS_BYTES - LDSCTL_OFF) / 4; u += NT) ((LAS unsigned*)(lds + LDSCTL_OFF))[u] = 0u;
    __syncthreads();
    if (threadIdx.x < 32) { const int i = threadIdx.x; const unsigned long long v = i < 30 ? (unsigned long long)KA.in[i] : (i == 30 ? (unsigned long long)KA.out : (unsigned long long)KA.ws);
        *(LAS unsigned long long*)(lds + LARGS_OFF + 8 * i) = v; }
    __syncthreads();
    const LA A{};
    (void)xcd_barrier_post((unsigned*)(KA.ws + WS_CTL) + CW_BAR, MISC + 8);
#define GRID_BAR() do { XcdBarrier b_; b_.bar = (unsigned*)(A.W() + WS_CTL) + CW_BAR; b_.x = xb_xcc_id(); b_.st = MISC + 8; xcd_barrier(b_); } while (0)

#pragma unroll 1
    for (int rep = 0; rep < REP_PRO; ++rep) {
    if (EN(0) && (REP_SEL & 1)) { IDS(); p0_rope(A, bid * NT + tid, G * NT); }
    if (EN(1) && (rep == 0 || (REP_SEL & 2))) { IDS(); p0_mod(A, lds, bid, G, tid, wave, lane); }
    if (EN(2) && (rep == 0 || (REP_SEL & 4))) { IDS(); p0_weights(A, lds, gw, NGW, wave, lane); }
    GRID_BAR();
    }

#pragma unroll 1
    for (int l = 0; l < DEPTH; ++l) {
        const float* modl = (const float*)(A.W() + WS_MOD) + (size_t)l * NMR * NMOD;
        const float* xin_p = l == 0 ? A.I(0) : A.O() + O_YP;
        const float* xin_s = l == 0 ? A.I(1) : A.O() + O_YS;
#pragma unroll 1
        for (int rep = 0; rep < REP_NA; ++rep) {
        if (EN(3)) { IDS(); phase_norm(A, l, 0, gw, NGW, lane); }
        GRID_BAR();
        }
#pragma unroll 1
        for (int rep = 0; rep < REP_G1; ++rep) {
        if (EN(4)) {   pg8::Gemm g{(const bf16*)(A.W() + WS_HA), (const bf16*)(A.W() + WS_WIN) + (size_t)l * NPROJ * DM, MPAD, NPROJ, DM}; pg8::StaticOrder S; S.init(MPAD, NPROJ, G, bid);
            pg8::EpiProj E{(bf16*)(A.W() + WS_PROJ), (float*)(A.W() + WS_DT)};
            pg8::gemm_phase<pg8::EpiProj, pg8::StaticOrder, PG8_ALIGN, PG8_SP2>(lds + RING_OFF, g, S, E);
        }
        GRID_BAR();
        }
#pragma unroll 1
        for (int rep = 0; rep < REP_MIX; ++rep) {
#pragma unroll 1
        for (int rep3 = 0; rep3 < REP_P3; ++rep3) {
        if (EN(6)) { IDS(); for (int u = bid; u < NBP * NCH * 2; u += G) ssd_chunk_state(A, lds, l, u, tid, wave, lane); }
        GRID_BAR();
        }
        if (EN(7)) { IDS(); ssd_scan(A, l, bid, G, tid); }
        for (int u = bid; u < 128 + 128 + 64 + 64 + 8; u += G) { IDS();
            if (u < 128) { if (EN(8)) attn_unit(A, lds, l, u, tid, wave, lane); }
            else if (u < 256) { if (EN(9)) sconv_unit(A, l, u - 128, tid); }
            else if (u < 320) { if (EN(10)) samp_ssd_unit(A, lds, l, u - 256, tid, wave, lane); }
            else if (u < 384) { if (EN(11)) samp_attn_unit(A, lds, l, u - 320, tid, wave, lane); }
            else { if (EN(12)) samp_sconv_unit(A, l, u - 384, tid); }
        }
        GRID_BAR();
#pragma unroll 1
        for (int rep5 = 0; rep5 < REP_P5; ++rep5) {
        if (EN(13)) { IDS(); for (int u = bid; u < NBP * NCH * 2; u += G) ssd_chunk_out(A, lds, l, u, tid, wave, lane); }
        GRID_BAR();
        }
        }
        if (EN(14)) {   pg8::Gemm g{(const bf16*)(A.W() + WS_MIX), (const bf16*)(A.W() + WS_WOUT) + (size_t)l * DM * DM, MP, DM, DM}; pg8::StaticOrder S; S.init(MP, DM, G, bid);
            pg8::EpiResid E{xin_p, A.O() + O_YP, modl + 2 * DM};
            pg8::gemm_phase<pg8::EpiResid, pg8::StaticOrder, PG8_ALIGN, PG8_SP2>(lds + RING_OFF, g, S, E);
            float* xo = A.O() + O_YS; const float* gate = modl + 2 * NMOD + 2 * DM; IDS();
            skinny_gemm(lds, (const bf16*)(A.W() + WS_MIX) + (size_t)MP * DM, g.Bt, DM, DM, bid, G, tid, wave, lane, [=](int row, int col, float v) { xo[(size_t)row * DM + col] = xin_s[(size_t)row * DM + col] + gate[(size_t)row * NMOD + col] * v; });
        }
        GRID_BAR();
#pragma unroll 1
        for (int rep = 0; rep < REP_NA; ++rep) {
        if (EN(15)) { IDS(); phase_norm(A, l, 1, gw, NGW, lane); }
        GRID_BAR();
        }
#pragma unroll 1
        for (int rep = 0; rep < REP_G1; ++rep) {
        if (EN(16)) {   pg8::Gemm g{(const bf16*)(A.W() + WS_HA), (const bf16*)(A.W() + WS_WUP) + (size_t)l * 2 * DFF * DM, MPAD, 2 * DFF, DM}; pg8::StaticOrder S; S.init(MPAD, 2 * DFF, G, bid);
            pg8::EpiPlain E{(bf16*)(A.W() + WS_GU), 2 * DFF};
            pg8::gemm_phase<pg8::EpiPlain, pg8::StaticOrder, PG8_ALIGN, PG8_SP2>(lds + RING_OFF, g, S, E);
        }
        GRID_BAR();
        }
#pragma unroll 1
        for (int rep = 0; rep < REP_NA; ++rep) {
        if (EN(17)) for (int u = bid; u < NBP * 64 * 11 + MS; u += G) { IDS(); if (u < NBP * 64 * 11) act_unit(A, l, u, tid); else samp_act_unit(A, l, u - NBP * 64 * 11, tid); }
        GRID_BAR();
        }
        if (EN(18)) {   pg8::Gemm g{(const bf16*)(A.W() + WS_ACT), (const bf16*)(A.W() + WS_WDN) + (size_t)l * DM * DFF, MP, DM, DFF}; pg8::StaticOrder S; S.init(MP, DM, G, bid);
            pg8::EpiResid E{A.O() + O_YP, A.O() + O_YP, modl + 5 * DM};
            pg8::gemm_phase<pg8::EpiResid, pg8::StaticOrder, PG8_ALIGN, PG8_SP2>(lds + RING_OFF, g, S, E);
            float* xo = A.O() + O_YS; const float* gate = modl + 2 * NMOD + 5 * DM; IDS();
            if (EN(19)) skinny_gemm(lds, (const bf16*)(A.W() + WS_ACT) + (size_t)MP * DFF, g.Bt, DM, DFF, bid, G, tid, wave, lane, [=](int row, int col, float v) { xo[(size_t)row * DM + col] += gate[(size_t)row * NMOD + col] * v; });
        }
        if (l + 1 < DEPTH) GRID_BAR();
    }
}

extern "C" void kernel_launch(void* const* d_in, const int* in_sizes, int n_in, void* d_out, int out_size, void* d_ws, size_t ws_size, hipStream_t stream) {
    static int grid = 0;
    if (grid == 0) {
        if (n_in != 30 || (size_t)out_size != O_END || ws_size < WS_END) { fprintf(stderr, "kernel_launch: unexpected shapes (n_in %d, out %d, ws %zu)\n", n_in, out_size, ws_size); grid = -1; return; }
        int dev = 0, cus = 0, per_cu = 0;
        if (hipGetDevice(&dev) != hipSuccess || hipDeviceGetAttribute(&cus, hipDeviceAttributeMultiprocessorCount, dev) != hipSuccess) { grid = -1; return; }
        if (hipFuncSetAttribute((const void*)hymba_fwd, hipFuncAttributeMaxDynamicSharedMemorySize, LDS_BYTES) != hipSuccess) { fprintf(stderr, "kernel_launch: hipFuncSetAttribute failed\n"); grid = -1; return; }
        if (hipOccupancyMaxActiveBlocksPerMultiprocessor(&per_cu, (const void*)hymba_fwd, NT, LDS_BYTES) != hipSuccess || per_cu < 1) { fprintf(stderr, "kernel_launch: occupancy query says %d blocks per CU\n", per_cu); }
        (void)hipGetLastError();
        grid = cus;
    }
    if (grid < 0) return;
    if (hipMemsetAsync((char*)d_ws + WS_CTL, 0, CTL_ZERO_BYTES, stream) != hipSuccess) return;
    Args a{};
    for (int i = 0; i < 30; ++i) a.in[i] = (const float*)d_in[i];
    a.out = (float*)d_out; a.ws = (unsigned char*)d_ws;
    hipLaunchKernelGGL(hymba_fwd, dim3(grid), dim3(NT), LDS_BYTES, stream, a);
    const hipError_t le = hipPeekAtLastError();
    if (le != hipSuccess) fprintf(stderr, "kernel_launch: launch failed: %s\n", hipGetErrorName(le));
}
```
